# Optimizing an MI355X kernel written in HIP

```python
import jax, jax.numpy as jnp
from jax import lax
import numpy as np

D_MODEL = 1024
BATCH = 8
SEQ = 4096
DEPTH = 4

ALPHA = (2 * DEPTH) ** 0.25
BETA = (8 * DEPTH) ** -0.25
LN_EPS = 1e-5
A_HEADS = 8
A_HEAD_DIM = 64
IDX_HEADS = 8
IDX_DIM = 64
TOPK_MAX = 256
Q_BLOCK = 128
G_HEADS = 4
G_DK = 128
G_DV = 128
G_RANK = 16
G_TAU = 16.0
G_CHUNK = 64
M_INNER = 2 * D_MODEL
M_HEADS = 4
M_DH = M_INNER // M_HEADS
M_CONV = 4
M_QKV_BLOCK = 4
M_CHUNK = 64
D_FF = 4 * D_MODEL

A_WIDTH = A_HEADS * A_HEAD_DIM
G_WIDTH = G_HEADS * G_DV
EVEN_SPLITS = (A_HEADS * A_HEAD_DIM, A_HEAD_DIM, A_HEAD_DIM,
               IDX_HEADS * IDX_DIM, IDX_DIM, IDX_HEADS,
               G_HEADS * G_DK, G_HEADS * G_DK, G_HEADS * G_DV, G_HEADS * G_DV, G_RANK)
EVEN_COLS = sum(EVEN_SPLITS)

kernel_name = "hybrid_dsa_gla_mlstm_deepnorm"


def layer_norm(x, g, b):
    xf = x.astype(jnp.float32)
    mu = jnp.mean(xf, axis=-1, keepdims=True)
    var = jnp.mean(jnp.square(xf - mu), axis=-1, keepdims=True)
    return ((xf - mu) * lax.rsqrt(var + LN_EPS) * g + b).astype(x.dtype)


def head_norm(x, g):
    xf = x.astype(jnp.float32)
    mu = jnp.mean(xf, axis=-1, keepdims=True)
    var = jnp.mean(jnp.square(xf - mu), axis=-1, keepdims=True)
    return (xf - mu) * lax.rsqrt(var + LN_EPS) * g


def to_chunks(t, L):
    B, H, S = t.shape[:3]
    return jnp.moveaxis(t.reshape(B, H, S // L, L, *t.shape[3:]), 2, 0)


def from_chunks(t):
    t = jnp.moveaxis(t, 0, 2)
    B, H, NC, L = t.shape[:4]
    return t.reshape(B, H, NC * L, *t.shape[4:])


def dsa_attention(q, k, v, qi, ki, wi):
    B, S = q.shape[:2]
    topk = min(TOPK_MAX, S // 4)
    nb = S // Q_BLOCK
    key_pos = jnp.arange(S)

    def block(args):
        qb, qib, wib, start = args
        qpos = start + jnp.arange(Q_BLOCK)
        causal = key_pos[None, :] <= qpos[:, None]
        logits = jnp.einsum('bqhd,bsd->bqhs', qib, ki) * IDX_DIM ** -0.5
        score = jnp.einsum('bqh,bqhs->bqs', wib * IDX_HEADS ** -0.5, jax.nn.relu(logits))
        score = jnp.where(causal[None], score.astype(jnp.float32), -jnp.inf)
        _, idx = lax.top_k(score, topk)
        valid = idx <= qpos[None, :, None]
        kg = jax.vmap(lambda kk, ii: kk[ii])(k, idx)
        vg = jax.vmap(lambda vv, ii: vv[ii])(v, idx)
        s = jnp.einsum('bqhd,bqkd->bqhk', qb, kg).astype(jnp.float32) * A_HEAD_DIM ** -0.5
        s = jnp.where(valid[:, :, None, :], s, -jnp.inf)
        p = jax.nn.softmax(s, axis=-1).astype(vg.dtype)
        return jnp.einsum('bqhk,bqkd->bqhd', p, vg)

    def blocks(t):
        return jnp.moveaxis(t.reshape(B, nb, Q_BLOCK, *t.shape[2:]), 1, 0)

    starts = jnp.arange(nb) * Q_BLOCK
    out = lax.map(block, (blocks(q), blocks(qi), blocks(wi), starts))
    return jnp.moveaxis(out, 0, 1).reshape(B, S, A_HEADS * A_HEAD_DIM)


def gla_chunked(q, k, v, log_a):
    B, H = q.shape[:2]
    tri = jnp.tril(jnp.ones((G_CHUNK, G_CHUNK), bool))

    def step(state, inp):
        qc, kc, vc, ac = inp
        bcum = jnp.cumsum(ac, axis=2)
        o_inter = jnp.einsum('bhld,bhde->bhle', qc * jnp.exp(bcum), state)
        diff = bcum[:, :, :, None, :] - bcum[:, :, None, :, :]
        diff = jnp.where(tri[None, None, :, :, None], diff, -jnp.inf)
        att = jnp.einsum('bhtd,bhsd,bhtsd->bhts', qc, kc, jnp.exp(diff))
        o_intra = jnp.einsum('bhts,bhse->bhte', att, vc)
        g = bcum[:, :, -1]
        kd = kc * jnp.exp(g[:, :, None, :] - bcum)
        state = jnp.exp(g)[..., None] * state + jnp.einsum('bhsd,bhse->bhde', kd, vc)
        return state, o_inter + o_intra

    s0 = jnp.zeros((B, H, G_DK, G_DV), jnp.float32)
    _, o = lax.scan(step, s0, (to_chunks(q, G_CHUNK), to_chunks(k, G_CHUNK),
                               to_chunks(v, G_CHUNK), to_chunks(log_a, G_CHUNK)))
    return from_chunks(o)


def mlstm_chunked(q, k, v, li, lf):
    B, H = q.shape[:2]
    tri = jnp.tril(jnp.ones((M_CHUNK, M_CHUNK), bool))

    def step(carry, inp):
        C, n, m = carry
        qc, kc, vc, lic, lfc = inp
        b = jnp.cumsum(lfc, axis=-1)
        D = b[..., :, None] - b[..., None, :] + lic[..., None, :]
        D = jnp.where(tri, D, -jnp.inf)
        inter = b + m[..., None]
        m_t = jnp.maximum(inter, jnp.max(D, axis=-1))
        w_inter = jnp.exp(inter - m_t)
        P = jnp.exp(D - m_t[..., None]) * jnp.einsum('bhtd,bhsd->bhts', qc, kc)
        num = w_inter[..., None] * jnp.einsum('bhtd,bhde->bhte', qc, C) + jnp.einsum('bhts,bhse->bhte', P, vc)
        den = w_inter * jnp.einsum('bhtd,bhd->bht', qc, n) + jnp.sum(P, axis=-1)
        h = num / jnp.maximum(jnp.abs(den), jnp.exp(-m_t))[..., None]
        g = b[..., -1]
        d_end = g[..., None] - b + lic
        m_new = jnp.maximum(g + m, jnp.max(d_end, axis=-1))
        wk = jnp.exp(d_end - m_new[..., None])
        decay = jnp.exp(g + m - m_new)
        C = decay[..., None, None] * C + jnp.einsum('bhs,bhsd,bhse->bhde', wk, kc, vc)
        n = decay[..., None] * n + jnp.einsum('bhs,bhsd->bhd', wk, kc)
        return (C, n, m_new), h

    init = (jnp.zeros((B, H, M_DH, M_DH), jnp.float32), jnp.zeros((B, H, M_DH), jnp.float32),
            jnp.zeros((B, H), jnp.float32))
    _, h = lax.scan(step, init, (to_chunks(q, M_CHUNK), to_chunks(k, M_CHUNK), to_chunks(v, M_CHUNK),
                                 to_chunks(li, M_CHUNK), to_chunks(lf, M_CHUNK)))
    return from_chunks(h)


def causal_conv(x, w):
    return lax.conv_general_dilated(x, w[:, None, :].astype(x.dtype), window_strides=(1,),
                                    padding=[(w.shape[0] - 1, 0)],
                                    dimension_numbers=('NWC', 'WIO', 'NWC'),
                                    feature_group_count=x.shape[-1])


def even_mixer(x, w_in, g_w2, g_b2, g_norm, w_out):
    B, S, _ = x.shape
    split_idx = np.cumsum(EVEN_SPLITS)[:-1].tolist()
    (a_q, a_k, a_v, i_q, i_k, i_w,
     g_q, g_k, g_v, g_r, g_lr) = jnp.split(x @ w_in, split_idx, axis=-1)
    a_out = dsa_attention(a_q.reshape(B, S, A_HEADS, A_HEAD_DIM), a_k, a_v,
                          i_q.reshape(B, S, IDX_HEADS, IDX_DIM), i_k, i_w)
    log_a = jax.nn.log_sigmoid((g_lr @ g_w2 + g_b2).astype(jnp.float32)) / G_TAU

    def heads(t, d):
        return t.reshape(B, S, G_HEADS, d).transpose(0, 2, 1, 3).astype(jnp.float32)

    o = gla_chunked(heads(g_q, G_DK) * G_DK ** -0.5, heads(g_k, G_DK), heads(g_v, G_DV), heads(log_a, G_DK))
    o = head_norm(o.transpose(0, 2, 1, 3), g_norm).reshape(B, S, G_WIDTH).astype(x.dtype)
    o = o * jax.nn.silu(g_r)
    return jnp.concatenate([a_out, o], axis=-1) @ w_out


def odd_mixer(x, w_in, conv_w, conv_b, w_q, w_k, w_v, w_gate, b_gate, skip, norm_g, w_out):
    B, S, _ = x.shape
    x_m, o_pre = jnp.split(x @ w_in, 2, axis=-1)
    x_c = jax.nn.silu(causal_conv(x_m, conv_w) + conv_b)

    def blockdiag(t, w):
        t = t.reshape(B, S, M_INNER // M_QKV_BLOCK, M_QKV_BLOCK)
        return jnp.einsum('bsnd,nde->bsne', t, w).reshape(B, S, M_INNER)

    q = blockdiag(x_c, w_q)
    k = blockdiag(x_c, w_k)
    v = blockdiag(x_m, w_v)
    gates = (jnp.concatenate([q, k, v], axis=-1) @ w_gate + b_gate).astype(jnp.float32)
    i_pre, f_pre = jnp.split(gates.transpose(0, 2, 1), 2, axis=1)

    def heads(t):
        return t.reshape(B, S, M_HEADS, M_DH).transpose(0, 2, 1, 3).astype(jnp.float32)

    h = mlstm_chunked(heads(q), heads(k) * M_DH ** -0.5, heads(v), i_pre, jax.nn.log_sigmoid(f_pre))
    h = h.transpose(0, 2, 1, 3) * jax.nn.sigmoid(o_pre.astype(jnp.float32)).reshape(B, S, M_HEADS, M_DH)
    y = head_norm(h, norm_g).reshape(B, S, M_INNER) + skip * x_c.astype(jnp.float32)
    return y.astype(x.dtype) @ w_out


def sqrelu_mlp(x, w1, w2):
    h = jax.nn.relu(x @ w1)
    return (h * h) @ w2


def setup_inputs(seed: int = 0) -> dict:
    key = jax.random.key(seed)
    ks = iter(jax.random.split(key, 32))

    def nrm(shape, scale):
        return jax.random.normal(next(ks), shape, jnp.float32) * scale

    NE = (DEPTH + 1) // 2
    NO = DEPTH // 2
    nblk = M_INNER // M_QKV_BLOCK
    f_bias = jnp.linspace(3.0, 6.0, M_HEADS, dtype=jnp.float32)[None, :] + nrm((NO, M_HEADS), 0.01)
    i_bias = nrm((NO, M_HEADS), 0.1)
    return {
        "x": nrm((BATCH, SEQ, D_MODEL), 1.0),
        "ev_w_in": nrm((NE, D_MODEL, EVEN_COLS), D_MODEL ** -0.5),
        "ev_g_w2": nrm((NE, G_RANK, G_HEADS * G_DK), G_RANK ** -0.5),
        "ev_g_b2": nrm((NE, G_HEADS * G_DK), 0.1),
        "ev_g_norm": 1.0 + nrm((NE, G_HEADS, G_DV), 0.02),
        "ev_w_out": nrm((NE, A_WIDTH + G_WIDTH, D_MODEL), (A_WIDTH + G_WIDTH) ** -0.5 * BETA),
        "od_w_in": nrm((NO, D_MODEL, 2 * M_INNER), D_MODEL ** -0.5),
        "od_conv_w": nrm((NO, M_CONV, M_INNER), M_CONV ** -0.5),
        "od_conv_b": nrm((NO, M_INNER), 0.02),
        "od_w_q": nrm((NO, nblk, M_QKV_BLOCK, M_QKV_BLOCK), M_QKV_BLOCK ** -0.5),
        "od_w_k": nrm((NO, nblk, M_QKV_BLOCK, M_QKV_BLOCK), M_QKV_BLOCK ** -0.5),
        "od_w_v": nrm((NO, nblk, M_QKV_BLOCK, M_QKV_BLOCK), M_QKV_BLOCK ** -0.5),
        "od_w_gate": nrm((NO, 3 * M_INNER, 2 * M_HEADS), (3 * M_INNER) ** -0.5),
        "od_b_gate": jnp.concatenate([i_bias, f_bias], axis=-1),
        "od_skip": 1.0 + nrm((NO, M_INNER), 0.02),
        "od_norm": 1.0 + nrm((NO, M_HEADS, M_DH), 0.02),
        "od_w_out": nrm((NO, M_INNER, D_MODEL), M_INNER ** -0.5 * BETA),
        "ln1_g": 1.0 + nrm((DEPTH, D_MODEL), 0.02),
        "ln1_b": nrm((DEPTH, D_MODEL), 0.02),
        "ln2_g": 1.0 + nrm((DEPTH, D_MODEL), 0.02),
        "ln2_b": nrm((DEPTH, D_MODEL), 0.02),
        "mlp_w1": nrm((DEPTH, D_MODEL, D_FF), D_MODEL ** -0.5),
        "mlp_w2": nrm((DEPTH, D_FF, D_MODEL), D_FF ** -0.5 * BETA),
    }


def reference(x, ev_w_in, ev_g_w2, ev_g_b2, ev_g_norm, ev_w_out,
              od_w_in, od_conv_w, od_conv_b, od_w_q, od_w_k, od_w_v, od_w_gate, od_b_gate,
              od_skip, od_norm, od_w_out,
              ln1_g, ln1_b, ln2_g, ln2_b, mlp_w1, mlp_w2):
    for l in range(DEPTH):
        j = l // 2
        if l % 2 == 0:
            h = even_mixer(x, ev_w_in[j], ev_g_w2[j], ev_g_b2[j], ev_g_norm[j], ev_w_out[j])
        else:
            h = odd_mixer(x, od_w_in[j], od_conv_w[j], od_conv_b[j], od_w_q[j], od_w_k[j], od_w_v[j],
                          od_w_gate[j], od_b_gate[j], od_skip[j], od_norm[j], od_w_out[j])
        x = layer_norm(ALPHA * x + h, ln1_g[l], ln1_b[l])
        x = layer_norm(ALPHA * x + sqrelu_mlp(x, mlp_w1[l], mlp_w2[l]), ln2_g[l], ln2_b[l])
    return x
```

```cpp
#include <hip/hip_runtime.h>
#include <cstdio>
#include <cstdint>
namespace pg8 {
#define PG8_LAS __attribute__((address_space(3)))
typedef unsigned short bf16_t;
typedef short bf16x8 __attribute__((ext_vector_type(8)));
typedef float f32x4 __attribute__((ext_vector_type(4)));
typedef unsigned u32x4 __attribute__((ext_vector_type(4)));
constexpr int BM = 256, BK = 64, HALF = 128, HTB = HALF * BK * 2  , STAGE_BYTES = 8 * HTB, NXCD = 8, WGM = 8;

__host__ __device__ __forceinline__ int lds_byte(int r, int c) { const int st = (r >> 4) * 2 + (c >> 5), rr = r & 15, cc = c & 31, ob = rr * 64 + cc * 2; return st * 1024 + (ob ^ (((ob >> 9) & 1) << 5)); }
__host__ __device__ __forceinline__ void stage_rc(int b, int& R, int& C) { const int st = b / 1024, sb = b % 1024, swz = sb ^ (((sb >> 9) & 1) << 5); R = (st >> 1) * 16 + swz / 64; C = (st & 1) * 32 + (swz % 64) / 2; }
__host__ __device__ __forceinline__ int perm32(int rho) { const int n = rho >> 4, i = rho & 15; return 8 * (i >> 2) + 4 * n + (i & 3); }

__device__ __forceinline__ int lane_id_v() { int x; asm volatile("v_mbcnt_lo_u32_b32 %0, -1, 0\n\tv_mbcnt_hi_u32_b32 %0, -1, %0" : "=v"(x)); return x; }
struct Unit { int pm, pn; };
struct Gemm { const bf16_t* A; const bf16_t* Bt; int M, N, K, lda; };

struct StaticOrder {
    int nM, nN, nwg, G, c;
    __host__ __device__ void init(int M, int N, int G_, int c_) { nM = M / BM; nN = N / BM; nwg = nM * nN; G = G_; c = c_; }
    __host__ __device__ bool next(int i, Unit& u) const {
        const long L = (long)i * G + c; if (L >= nwg) return false;
        int wgid = (int)L; { const int q = nwg / NXCD, r = nwg % NXCD, xcd = wgid % NXCD, off = wgid / NXCD; wgid = (xcd < r ? xcd * (q + 1) : r * (q + 1) + (xcd - r) * q) + off; }
        const int nig = WGM * nN, gid = wgid / nig, fm = gid * WGM, gsz = (nM - fm) < WGM ? (nM - fm) : WGM;
        u.pm = fm + ((wgid % nig) % gsz); u.pn = (wgid % nig) / gsz; return true;
    }
    __device__ __forceinline__ void a_ready(const Unit&) const {}
    __device__ __forceinline__ void done(const Unit&) const {}
};

__device__ __forceinline__ unsigned cvt_pk_bf16(float lo, float hi) { unsigned r; asm volatile("v_cvt_pk_bf16_f32 %0, %1, %2" : "=v"(r) : "v"(lo), "v"(hi)); return r; }
__device__ __forceinline__ float bf_lo(unsigned w) { return __uint_as_float(w << 16); }
__device__ __forceinline__ float bf_hi(unsigned w) { return __uint_as_float(w & 0xffff0000u); }

template <int ACT> struct EpiBf16 {
    static constexpr bool PERM = true, AFTER_DRAIN = false;
    bf16_t* O; int ldc;
    __device__ __forceinline__ void operator()(const f32x4 (&acc)[2][2][4][2], const Unit& u, int wr, int wc, int fr, int fq) const {
        const int row0 = u.pm * BM + wr * 64 + fr, col0 = u.pn * BM + wc * 32 + 8 * fq;
#pragma unroll
        for (int ai = 0; ai < 2; ++ai)
#pragma unroll
            for (int m = 0; m < 4; ++m) { bf16_t* rowp = O + (size_t)(row0 + ai * HALF + m * 16) * ldc + col0;
#pragma unroll
                for (int bj = 0; bj < 2; ++bj) { f32x4 v0 = acc[ai][bj][m][0], v1 = acc[ai][bj][m][1];
                    if (ACT == 1) {
#pragma unroll
                        for (int j = 0; j < 4; ++j) { const float a = fmaxf(v0[j], 0.f), b = fmaxf(v1[j], 0.f); v0[j] = a * a; v1[j] = b * b; } }
                    u32x4 w; w.x = cvt_pk_bf16(v0[0], v0[1]); w.y = cvt_pk_bf16(v0[2], v0[3]); w.z = cvt_pk_bf16(v1[0], v1[1]); w.w = cvt_pk_bf16(v1[2], v1[3]);
                    *(u32x4*)(rowp + bj * HALF) = w; } }
    }
};
struct EpiOddIn {
    static constexpr bool PERM = true, AFTER_DRAIN = false;
    bf16_t* XM; bf16_t* OG;
    __device__ __forceinline__ void operator()(const f32x4 (&acc)[2][2][4][2], const Unit& u, int wr, int wc, int fr, int fq) const {
        const bool gate = u.pn >= 8;
        bf16_t* base = gate ? OG : XM;
        const int row0 = u.pm * BM + wr * 64 + fr, col0 = (u.pn & 7) * BM + wc * 32 + 8 * fq;
#pragma unroll
        for (int ai = 0; ai < 2; ++ai)
#pragma unroll
            for (int m = 0; m < 4; ++m) { bf16_t* rowp = base + (size_t)(row0 + ai * HALF + m * 16) * 2048 + col0;
#pragma unroll
                for (int bj = 0; bj < 2; ++bj) { f32x4 v0 = acc[ai][bj][m][0], v1 = acc[ai][bj][m][1];
                    if (gate) {
#pragma unroll
                        for (int j = 0; j < 4; ++j) { v0[j] = __builtin_amdgcn_rcpf(1.0f + __expf(-v0[j])); v1[j] = __builtin_amdgcn_rcpf(1.0f + __expf(-v1[j])); } }
                    u32x4 w; w.x = cvt_pk_bf16(v0[0], v0[1]); w.y = cvt_pk_bf16(v0[2], v0[3]); w.z = cvt_pk_bf16(v1[0], v1[1]); w.w = cvt_pk_bf16(v1[2], v1[3]);
                    *(u32x4*)(rowp + bj * HALF) = w; } }
    }
};
struct EpiResid {
    static constexpr bool PERM = false, AFTER_DRAIN = false;
    const bf16_t* XB; float* T; float alpha;
    __device__ __forceinline__ void operator()(const f32x4 (&acc)[2][2][4][2], const Unit& u, int wr, int wc, int fr, int fq) const {
        const int row0 = u.pm * BM + wr * 64 + fr, col0 = u.pn * BM + wc * 32 + 4 * fq;
#pragma unroll
        for (int ai = 0; ai < 2; ++ai)
#pragma unroll
            for (int m = 0; m < 4; ++m) { const size_t off = (size_t)(row0 + ai * HALF + m * 16) * 1024 + col0;
#pragma unroll
                for (int bj = 0; bj < 2; ++bj)
#pragma unroll
                    for (int n = 0; n < 2; ++n) { const size_t o2 = off + bj * HALF + n * 16; const uint2 xb = *(const uint2*)(XB + o2);
                        f32x4 o; o[0] = alpha * bf_lo(xb.x) + acc[ai][bj][m][n][0]; o[1] = alpha * bf_hi(xb.x) + acc[ai][bj][m][n][1];
                        o[2] = alpha * bf_lo(xb.y) + acc[ai][bj][m][n][2]; o[3] = alpha * bf_hi(xb.y) + acc[ai][bj][m][n][3];
                        *(f32x4*)(T + o2) = o; } }
    }
};

template <class Epi, class Sched, bool ALIGN_EPI = false, bool SP2 = false>
__device__ __forceinline__ void gemm_phase(PG8_LAS unsigned char* lds, const Gemm g, const Sched& S, const Epi& E, int wid_in) {
    const int wid = wid_in, lane = lane_id_v(), tid = wid * 64 + lane, wr = wid >> 2, wc = wid & 3, fr = lane & 15, fq = lane >> 4;
    const int K = g.K, nt = K / BK;
    unsigned voffA[2], voffB[2];
#pragma unroll
    for (int i = 0; i < 2; ++i) { int R, C; stage_rc(tid * 16 + i * 8192, R, C); const int Rb = Epi::PERM ? ((R & ~31) + perm32(R & 31)) : R;
        voffA[i] = (unsigned)(R * g.lda + C) * 2u; voffB[i] = (unsigned)(Rb * K + C) * 2u; }
    const size_t kstep = (size_t)(BK * 2);
    const size_t hstep = (size_t)HALF * K * 2;
    const size_t tstep = 2 * hstep;
    const size_t hstepA = (size_t)HALF * g.lda * 2, tstepA = 2 * hstepA;
    const unsigned ldsw = (unsigned)wid * 1024u;
    const int aoff = lds_byte(wr * 64 + fr, fq * 8), boff = lds_byte(wc * 32 + fr, fq * 8);
#define PG8_SA(b, h) (((b) * 2 + (h)) * HTB)
#define PG8_SB(b, h) ((4 + (b) * 2 + (h)) * HTB)
#define PG8_STAGE(bufoff, gbase, voff) do { _Pragma("unroll") for (int _i = 0; _i < 2; ++_i) \
        __builtin_amdgcn_global_load_lds((const unsigned*)((const char*)(gbase) + (voff)[_i]), (PG8_LAS unsigned*)(lds + (bufoff) + ldsw + _i * 8192), 16, 0, 0); } while (0)
#define PG8_LDA(dst, b, h) do { _Pragma("unroll") for (int m = 0; m < 4; ++m) _Pragma("unroll") for (int k = 0; k < 2; ++k) dst[m][k] = *(const PG8_LAS bf16x8*)(lds + PG8_SA(b, h) + aoff + m * 2048 + k * 1024); } while (0)
#define PG8_LDB(dst, b, h) do { _Pragma("unroll") for (int n = 0; n < 2; ++n) _Pragma("unroll") for (int k = 0; k < 2; ++k) dst[n][k] = *(const PG8_LAS bf16x8*)(lds + PG8_SB(b, h) + boff + n * 2048 + k * 1024); } while (0)
#define PG8_MMA(ai, bj, At, Bt) do { __builtin_amdgcn_s_setprio(1); _Pragma("unroll") for (int m = 0; m < 4; ++m) _Pragma("unroll") for (int n = 0; n < 2; ++n) _Pragma("unroll") for (int k = 0; k < 2; ++k) \
        acc[ai][bj][m][n] = __builtin_amdgcn_mfma_f32_16x16x32_bf16(Bt[n][k], At[m][k], acc[ai][bj][m][n], 0, 0, 0); __builtin_amdgcn_s_setprio(0); } while (0)
#define PG8_WAIT_V(n) asm volatile("s_waitcnt vmcnt(" #n ")" ::: "memory")
#define PG8_WAIT_L(n) asm volatile("s_waitcnt lgkmcnt(" #n ")" ::: "memory")
#define PG8_BAR __builtin_amdgcn_s_barrier()
#define PG8_SCHED __builtin_amdgcn_sched_barrier(0)
    Unit cur, nxt; int ui = 0;
    if (!S.next(0, cur)) return;
    f32x4 acc[2][2][4][2];
#pragma unroll
    for (int a = 0; a < 2; ++a)
#pragma unroll
        for (int b = 0; b < 2; ++b)
#pragma unroll
            for (int m = 0; m < 4; ++m)
#pragma unroll
                for (int n = 0; n < 2; ++n) acc[a][b][m][n] = (f32x4){0.f, 0.f, 0.f, 0.f};
    bf16x8 At[4][2], B0[2][2], B1[2][2];
    const char* cA = (const char*)g.A + (size_t)cur.pm * tstepA; const char* cB = (const char*)g.Bt + (size_t)cur.pn * tstep;
    S.a_ready(cur);
    if constexpr (SP2) {
        PG8_STAGE(PG8_SB(0, 0), cB, voffB); PG8_STAGE(PG8_SB(0, 1), cB + hstep, voffB); PG8_STAGE(PG8_SA(0, 0), cA, voffA); PG8_STAGE(PG8_SA(0, 1), cA + hstepA, voffA);
        if (wr == 1) PG8_BAR;
        PG8_WAIT_V(2); PG8_BAR;
        PG8_STAGE(PG8_SB(1, 0), cB + kstep, voffB); PG8_STAGE(PG8_SA(1, 0), cA + kstep, voffA); PG8_STAGE(PG8_SB(1, 1), cB + hstep + kstep, voffB);
        PG8_WAIT_V(6); PG8_BAR;
    } else {
        PG8_STAGE(PG8_SB(0, 0), cB, voffB); PG8_STAGE(PG8_SA(0, 0), cA, voffA); PG8_STAGE(PG8_SB(0, 1), cB + hstep, voffB); PG8_STAGE(PG8_SA(0, 1), cA + hstepA, voffA);
        if (wr == 1) PG8_BAR;
        PG8_WAIT_V(4); PG8_BAR;
        PG8_STAGE(PG8_SB(1, 0), cB + kstep, voffB); PG8_STAGE(PG8_SA(1, 0), cA + kstep, voffA); PG8_STAGE(PG8_SB(1, 1), cB + hstep + kstep, voffB);
        PG8_WAIT_V(6); PG8_BAR;
    }
    for (;;) {
        const bool has_next = S.next(ui + 1, nxt);
        const char* nA = has_next ? (const char*)g.A + (size_t)nxt.pm * tstepA : cA; const char* nB = has_next ? (const char*)g.Bt + (size_t)nxt.pn * tstep : cB;
        for (int t = 0; t < nt; t += 2) {
            const bool last = (t == nt - 2);
            const char* a1 = cA + (size_t)(t + 1) * kstep;
            const char* a2 = last ? nA : cA + (size_t)(t + 2) * kstep; const char* b2 = last ? nB : cB + (size_t)(t + 2) * kstep;
            const char* a3 = a2 + kstep; const char* b3 = b2 + kstep;
            if (last && has_next) S.a_ready(nxt);
            if constexpr (SP2) {
            PG8_LDB(B0, 0, 0); PG8_LDB(B1, 0, 1); PG8_SCHED; PG8_LDA(At, 0, 0); PG8_STAGE(PG8_SA(1, 1), a1 + hstepA, voffA);
            PG8_WAIT_V(8); PG8_WAIT_L(0); PG8_BAR; PG8_MMA(0, 0, At, B0); PG8_MMA(0, 1, At, B1); PG8_BAR; PG8_SCHED;
            PG8_LDA(At, 0, 1); PG8_STAGE(PG8_SB(0, 0), b2, voffB); PG8_STAGE(PG8_SB(0, 1), b2 + hstep, voffB); PG8_STAGE(PG8_SA(0, 0), a2, voffA);
            PG8_WAIT_V(8); PG8_WAIT_L(0); PG8_BAR; PG8_MMA(1, 0, At, B0); PG8_MMA(1, 1, At, B1); PG8_BAR; PG8_SCHED;
            PG8_LDB(B0, 1, 0); PG8_LDB(B1, 1, 1); PG8_SCHED; PG8_LDA(At, 1, 0); PG8_STAGE(PG8_SA(0, 1), a2 + hstepA, voffA);
            PG8_WAIT_V(8); PG8_WAIT_L(0); PG8_BAR; PG8_MMA(0, 0, At, B0); PG8_MMA(0, 1, At, B1); PG8_BAR; PG8_SCHED;
            PG8_LDA(At, 1, 1); PG8_STAGE(PG8_SB(1, 0), b3, voffB); PG8_STAGE(PG8_SB(1, 1), b3 + hstep, voffB); PG8_STAGE(PG8_SA(1, 0), a3, voffA);
            PG8_WAIT_V(8); PG8_WAIT_L(0); PG8_BAR; PG8_MMA(1, 0, At, B0); PG8_MMA(1, 1, At, B1); PG8_BAR; PG8_SCHED;
            } else {
            PG8_LDB(B0, 0, 0); PG8_SCHED; PG8_LDA(At, 0, 0); PG8_STAGE(PG8_SA(1, 1), a1 + hstepA, voffA);
            PG8_WAIT_L(8); PG8_BAR; PG8_WAIT_L(0); PG8_MMA(0, 0, At, B0); PG8_BAR; PG8_SCHED;
            PG8_LDB(B1, 0, 1); PG8_STAGE(PG8_SB(0, 0), b2, voffB);
            PG8_BAR; PG8_WAIT_L(0); PG8_MMA(0, 1, At, B1); PG8_BAR;
            PG8_LDA(At, 0, 1); PG8_STAGE(PG8_SA(0, 0), a2, voffA);
            PG8_BAR; PG8_WAIT_L(0); PG8_MMA(1, 0, At, B0); PG8_BAR; PG8_SCHED;
            PG8_STAGE(PG8_SB(0, 1), b2 + hstep, voffB);
            PG8_WAIT_V(6); PG8_BAR; PG8_MMA(1, 1, At, B1); PG8_BAR;
            PG8_LDB(B0, 1, 0); PG8_SCHED; PG8_LDA(At, 1, 0); PG8_STAGE(PG8_SA(0, 1), a2 + hstepA, voffA);
            PG8_WAIT_L(8); PG8_BAR; PG8_WAIT_L(0); PG8_MMA(0, 0, At, B0); PG8_BAR; PG8_SCHED;
            PG8_LDB(B1, 1, 1); PG8_STAGE(PG8_SB(1, 0), b3, voffB);
            PG8_BAR; PG8_WAIT_L(0); PG8_MMA(0, 1, At, B1); PG8_BAR;
            PG8_LDA(At, 1, 1); PG8_STAGE(PG8_SA(1, 0), a3, voffA);
            PG8_BAR; PG8_WAIT_L(0); PG8_MMA(1, 0, At, B0); PG8_BAR; PG8_SCHED;
            PG8_STAGE(PG8_SB(1, 1), b3 + hstep, voffB);
            PG8_WAIT_V(6); PG8_BAR; PG8_MMA(1, 1, At, B1); PG8_BAR;
            }
        }
        if constexpr (ALIGN_EPI) { if (wr == 0) PG8_BAR; }
        if constexpr (!Epi::AFTER_DRAIN) { E(acc, cur, wr, wc, fr, fq); S.done(cur); }
        if (!has_next) break;
#pragma unroll
        for (int a = 0; a < 2; ++a)
#pragma unroll
            for (int b = 0; b < 2; ++b)
#pragma unroll
                for (int m = 0; m < 4; ++m)
#pragma unroll
                    for (int n = 0; n < 2; ++n) acc[a][b][m][n] = (f32x4){0.f, 0.f, 0.f, 0.f};
        cur = nxt; cA = nA; cB = nB; ++ui;
        if constexpr (ALIGN_EPI) { if (wr == 1) PG8_BAR; }
    }
    PG8_WAIT_V(0);
    if constexpr (!ALIGN_EPI) { if (wr == 0) PG8_BAR; }
    PG8_BAR;
    if constexpr (Epi::AFTER_DRAIN) { E.fused(acc, cur, wr, wc, fr, fq, lds, wid, lane); S.done(cur); }
#undef PG8_SA
#undef PG8_SB
#undef PG8_STAGE
#undef PG8_LDA
#undef PG8_LDB
#undef PG8_MMA
#undef PG8_WAIT_V
#undef PG8_WAIT_L
#undef PG8_BAR
#undef PG8_SCHED
}
}
constexpr int BATCH = 8, SEQ = 4096, DM = 1024, DEPTH = 4, FF = 4096;
constexpr int M = BATCH * SEQ;
constexpr float ALPHA = 1.6817928305074290f;
constexpr float LN_EPS = 1e-5f;
constexpr int NWAVES = 8;
constexpr int EVW = 3328;
constexpr int EC_AQ = 0, EC_GR = 512, EC_GQ = 1024, EC_GK = 1536, EC_GV = 2048, EC_IQ = 2560, EC_AK = 3072, EC_AV = 3136, EC_IK = 3200, EC_IW = 3264, EC_GLR = 3296;
constexpr int EV_SRCW = 3288;
constexpr int MI = 2048, MH = 4, MDH = 512, MCH = 64, NCH = SEQ / MCH;

constexpr size_t MiB = 1u << 20;
constexpr size_t WS_CTL = 0, CTL_ZERO_BYTES = 1 * MiB;
constexpr size_t WS_WIN = 1 * MiB, WS_WOUT = 9 * MiB, WS_W1 = 13 * MiB, WS_W2 = 21 * MiB;
constexpr size_t WS_SMALL = 29 * MiB;
constexpr size_t WS_XB = 41 * MiB;
constexpr size_t WS_AUX = 105 * MiB;
constexpr size_t WS_BIG = 121 * MiB;
constexpr size_t WS_END = 505 * MiB;
constexpr size_t SM_GATEW = 0;
constexpr size_t SM_KFOLD = 512 * 1024;
constexpr size_t SM_LI = 1 * MiB;
constexpr size_t SM_BC = 2 * MiB;
constexpr size_t SM_CHG = 3 * MiB;
constexpr size_t SM_WIN = 4 * MiB;
constexpr size_t SM_DEN = 5 * MiB;
constexpr size_t SM_EMM = 6 * MiB;
constexpr size_t SM_WK = 7 * MiB;
constexpr size_t SM_DEC = 8 * MiB;
constexpr int CW_BAR = 4096;

constexpr int RING_BYTES = 131072;
constexpr int LDSX_OFF = RING_BYTES;
constexpr int MISC_OFF = 145408;
constexpr int LDS_BYTES = 147456;

#define GAS __attribute__((address_space(1)))
#define LAS __attribute__((address_space(3)))
typedef unsigned short bf16;
typedef unsigned v4u __attribute__((ext_vector_type(4)));
typedef unsigned v2u __attribute__((ext_vector_type(2)));
typedef float f32x4 __attribute__((ext_vector_type(4)));
typedef float f32x16 __attribute__((ext_vector_type(16)));
typedef short bf16x8 __attribute__((ext_vector_type(8)));
typedef short s16x4 __attribute__((ext_vector_type(4)));
typedef GAS unsigned gu32;
#define RLX_AGENT __ATOMIC_RELAXED, __HIP_MEMORY_SCOPE_AGENT
#define LDS_WAIT() asm volatile("s_waitcnt lgkmcnt(0)" ::: "memory")
#define VM_WAIT() asm volatile("s_waitcnt vmcnt(0)" ::: "memory")
__device__ __forceinline__ unsigned f2bf(float f) { unsigned u = __builtin_bit_cast(unsigned, f); return (u + 0x7fffu + ((u >> 16) & 1u)) >> 16; }
__device__ __forceinline__ unsigned pk2(float lo, float hi) { return f2bf(lo) | (f2bf(hi) << 16); }
__device__ __forceinline__ float bf2f(unsigned short b) { return __uint_as_float(((unsigned)b) << 16); }
__device__ __forceinline__ float bflo(unsigned w) { return __uint_as_float(w << 16); }
__device__ __forceinline__ float bfhi(unsigned w) { return __uint_as_float(w & 0xffff0000u); }
__device__ __forceinline__ float shx(float v, int o, int lane) { return __builtin_bit_cast(float, __builtin_amdgcn_ds_bpermute((lane ^ o) << 2, __builtin_bit_cast(int, v))); }
__device__ __forceinline__ float shi(float v, int src) { return __builtin_bit_cast(float, __builtin_amdgcn_ds_bpermute(src << 2, __builtin_bit_cast(int, v))); }
__device__ __forceinline__ float wave_sum(float v, int lane) {
#pragma unroll
    for (int o = 1; o < 64; o <<= 1) v += shx(v, o, lane);
    return v;
}
__device__ __forceinline__ float sigmoidf_(float x) { return __builtin_amdgcn_rcpf(1.0f + __expf(-x)); }
__device__ __forceinline__ float logsigmoidf_(float x) { return fminf(x, 0.f) - log1pf(__expf(-fabsf(x))); }
#define MFMA16(a, b, c) __builtin_amdgcn_mfma_f32_16x16x32_bf16((a), (b), (c), 0, 0, 0)
#define MFMA32(a, b, c) __builtin_amdgcn_mfma_f32_32x32x16_bf16((a), (b), (c), 0, 0, 0)
__device__ __forceinline__ int lane_id() { int x; asm volatile("v_mbcnt_lo_u32_b32 %0, -1, 0\n\tv_mbcnt_hi_u32_b32 %0, -1, %0" : "=v"(x)); return x; }
#define XB_TMO      128
#define XB_XCNT(j)  (256  + 64 * (j))
#define XB_XSUB(j)  (1280 + 64 * (j))
#define XB_XGEN(j)  (2304 + 64 * (j))
#define XB_TOP      3328
#define XB_TOPGEN   3392
#define XCD_BAR_WORDS 3456
#define XB_SPIN_CAP (1u << 18)

__device__ __forceinline__ unsigned xb_ld(unsigned* p)              { return __hip_atomic_load(p, __ATOMIC_RELAXED, __HIP_MEMORY_SCOPE_AGENT); }
__device__ __forceinline__ unsigned xb_add(unsigned* p, unsigned v) { return __hip_atomic_fetch_add(p, v, __ATOMIC_RELAXED, __HIP_MEMORY_SCOPE_AGENT); }
__device__ __forceinline__ unsigned xb_xcc_id() { return (unsigned)__builtin_amdgcn_s_getreg((3 << 11) | 20) & 0xFu; }
#define XB_SPIN(cond, bar) do { unsigned _sp = 0; while (cond) { __builtin_amdgcn_s_sleep(1); \
    if ((++_sp & 255u) == 0u) { if (xb_ld(&(bar)[XB_TMO])) break; if (_sp > XB_SPIN_CAP) { atomicAdd(&(bar)[XB_TMO], 1u); break; } } } } while (0)

struct XcdBarrier {
    unsigned* bar; unsigned x;
    volatile LAS unsigned* st;
};

__device__ __forceinline__ XcdBarrier xcd_barrier_post(unsigned* bar, volatile LAS unsigned* st, int wave) {
    XcdBarrier b; b.bar = bar; b.x = xb_xcc_id(); b.st = st;
    if (wave == 0 && lane_id() == 0) (void)xb_add(&bar[XB_XCNT(b.x)], 1u);
    return b;
}
__device__ __forceinline__ void xcd_barrier_complete(unsigned* bar, unsigned x, unsigned& nloc, unsigned& nx) {
    const unsigned G = gridDim.x * gridDim.y * gridDim.z;
    unsigned sum, cnt, mine, sp = 0u;
    for (;;) {
        sum = 0u; cnt = 0u; mine = 0u;
#pragma unroll
        for (unsigned j = 0; j < 16; ++j) { const unsigned c = xb_ld(&bar[XB_XCNT(j)]); sum += c; cnt += (c > 0u) ? 1u : 0u; mine = (j == x) ? c : mine; }
        if (sum == G) break;
        __builtin_amdgcn_s_sleep(1);
        if ((++sp & 255u) == 0u) { if (xb_ld(&bar[XB_TMO])) break; if (sp > XB_SPIN_CAP) { atomicAdd(&bar[XB_TMO], 1u); break; } }
    }
    nloc = mine > 0u ? mine : 1u; nx = cnt > 0u ? cnt : 1u;
}

__device__ __forceinline__ void xcd_barrier(const XcdBarrier& b, int wave) {
    asm volatile("s_waitcnt vmcnt(0)" ::: "memory");
    __syncthreads();
    if (wave == 0 && lane_id() == 0) {
        unsigned* bar = b.bar; asm volatile("" : "+s"(bar));
        __builtin_amdgcn_s_waitcnt(0);
        unsigned nloc = b.st[0], nx = b.st[1];
        if (nloc == 0u) { xcd_barrier_complete(bar, b.x, nloc, nx); b.st[0] = nloc; b.st[1] = nx; }
        const unsigned old = xb_add(&bar[XB_XSUB(b.x)], 1u);
        const unsigned gen = old / nloc;
        if (old + 1u == (gen + 1u) * nloc) {
            __builtin_amdgcn_fence(__ATOMIC_RELEASE, "agent");
            asm volatile("s_waitcnt vmcnt(0)" ::: "memory");
            const unsigned og = xb_add(&bar[XB_TOP], 1u);
            const unsigned tg = og / nx;
            if (og + 1u == (tg + 1u) * nx) xb_add(&bar[XB_TOPGEN], 1u);
            else XB_SPIN(xb_ld(&bar[XB_TOPGEN]) == tg, bar);
            __builtin_amdgcn_fence(__ATOMIC_ACQUIRE, "agent");
            xb_add(&bar[XB_XGEN(b.x)], 1u);
            asm volatile("s_waitcnt vmcnt(0)" ::: "memory");
        } else {
            XB_SPIN(xb_ld(&bar[XB_XGEN(b.x)]) == gen, bar);
            __builtin_amdgcn_fence(__ATOMIC_ACQUIRE, "agent");
            asm volatile("s_waitcnt vmcnt(0)" ::: "memory");
        }
    }
    __syncthreads();
}

struct Args { const float* in[23]; float* out; unsigned char* ws; };
typedef const __attribute__((address_space(4))) Args CArgs;
enum { I_X = 0, I_EV_WIN, I_EV_GW2, I_EV_GB2, I_EV_GNORM, I_EV_WOUT, I_OD_WIN, I_OD_CONVW, I_OD_CONVB, I_OD_WQ, I_OD_WK, I_OD_WV, I_OD_WGATE, I_OD_BGATE,
       I_OD_SKIP, I_OD_NORM, I_OD_WOUT, I_LN1G, I_LN1B, I_LN2G, I_LN2B, I_W1, I_W2 };
struct Frame { int wave, vcu, G; CArgs* ap; };
__device__ __forceinline__ int opq_v(int x) { asm volatile("" : "+v"(x)); return x; }
__device__ __forceinline__ int opq_s(int x) { asm volatile("" : "+s"(x)); return x; }
__device__ __forceinline__ LAS unsigned char* lds_base() { extern __shared__ __attribute__((aligned(16))) unsigned char lds_raw[]; return (LAS unsigned char*)lds_raw; }
__device__ __forceinline__ CArgs* opq_p(CArgs* p) { asm volatile("" : "+s"(p)); return p; }
__device__ __forceinline__ LAS unsigned char* opq_l(LAS unsigned char* p) { asm volatile("" : "+s"(p)); return p; }
#define PHASE_UNIFORMS() const int wave = opq_s(F.wave), vcu = opq_s(F.vcu), G = opq_s(F.G), bid = opq_s((int)blockIdx.x); (void)wave; (void)vcu; (void)G; (void)bid

__device__ __forceinline__ void transpose_item(const float* W, int K, int Ns, bf16* WT, int k0, int n0, int sc0, int valid, LAS float* scr, int lane) {
    const int c = lane & 31;
#pragma unroll 8
    for (int i = 0; i < 32; ++i) { const int kk = 2 * i + (lane >> 5); scr[kk * 33 + c] = (c < valid) ? W[(size_t)(k0 + kk) * Ns + sc0 + c] : 0.f; }
    LDS_WAIT(); asm volatile("" ::: "memory");
    const int c8 = lane & 7;
#pragma unroll
    for (int j = 0; j < 4; ++j) { const int n = (lane >> 3) + 8 * j; const LAS float* s = scr + (8 * c8) * 33 + n;
        v4u o; o.x = pk2(s[0 * 33], s[1 * 33]); o.y = pk2(s[2 * 33], s[3 * 33]); o.z = pk2(s[4 * 33], s[5 * 33]); o.w = pk2(s[6 * 33], s[7 * 33]);
        *(GAS v4u*)(WT + (size_t)(n0 + n) * K + k0 + 8 * c8) = o; }
    LDS_WAIT(); asm volatile("" ::: "memory");
}
__device__ __forceinline__ void ev_group(int nb, int& src, int& valid) {
    const int c0 = nb * 32; valid = 32;
    if (c0 < EC_GR) src = 0 + c0;
    else if (c0 < EC_GQ) src = 2760 + (c0 - EC_GR);
    else if (c0 < EC_GK) src = 1224 + (c0 - EC_GQ);
    else if (c0 < EC_GV) src = 1736 + (c0 - EC_GK);
    else if (c0 < EC_IQ) src = 2248 + (c0 - EC_GV);
    else if (c0 < EC_AK) src = 640 + (c0 - EC_IQ);
    else if (c0 < EC_AV) src = 512 + (c0 - EC_AK);
    else if (c0 < EC_IK) src = 576 + (c0 - EC_AV);
    else if (c0 < EC_IW) src = 1152 + (c0 - EC_IK);
    else if (c0 < EC_GLR) { src = 1216; valid = 8; }
    else { src = 3272; valid = 16; }
}
__device__ __forceinline__ void convert_layer(const Frame& F, int l) {
    CArgs* ap = opq_p(F.ap); unsigned char* ws = ap->ws;
    PHASE_UNIFORMS(); const int lane = opq_v(lane_id());
    LAS float* scr = (LAS float*)(opq_l(lds_base()) + wave * 16384);
    const int gw = vcu * NWAVES + wave, NGW = G * NWAVES;
    const int j = l >> 1; const bool even = (l & 1) == 0;
    bf16* WIN = (bf16*)(ws + WS_WIN); bf16* WOUT = (bf16*)(ws + WS_WOUT); bf16* W1 = (bf16*)(ws + WS_W1); bf16* W2 = (bf16*)(ws + WS_W2);
    const int n_in = even ? 16 * (EVW / 32) : 16 * (4096 / 32);
    const int n_out = even ? 16 * 32 : 32 * 32;
    const int n_1 = 16 * 128, n_2 = 64 * 32;
    const int total = n_in + n_out + n_1 + n_2;
    for (int it = gw; it < total; it += NGW) {
        int r = it;
        if (r < n_in) {
            if (even) { const int nblk = EVW / 32, kb = r / nblk, nb = r % nblk; int src, valid; ev_group(nb, src, valid);
                transpose_item(ap->in[I_EV_WIN] + (size_t)j * 1024 * EV_SRCW, 1024, EV_SRCW, WIN, 64 * kb, 32 * nb, src, valid, scr, lane); }
            else { const int nblk = 128, kb = r / nblk, nb = r % nblk;
                transpose_item(ap->in[I_OD_WIN] + (size_t)j * 1024 * 4096, 1024, 4096, WIN, 64 * kb, 32 * nb, 32 * nb, 32, scr, lane); }
            continue; }
        r -= n_in;
        if (r < n_out) { const int kb = r / 32, nb = r % 32;
            if (even) transpose_item(ap->in[I_EV_WOUT] + (size_t)j * 1024 * 1024, 1024, 1024, WOUT, 64 * kb, 32 * nb, 32 * nb, 32, scr, lane);
            else transpose_item(ap->in[I_OD_WOUT] + (size_t)j * 2048 * 1024, 2048, 1024, WOUT, 64 * kb, 32 * nb, 32 * nb, 32, scr, lane);
            continue; }
        r -= n_out;
        if (r < n_1) { const int kb = r / 128, nb = r % 128; transpose_item(ap->in[I_W1] + (size_t)l * 1024 * 4096, 1024, 4096, W1, 64 * kb, 32 * nb, 32 * nb, 32, scr, lane); continue; }
        r -= n_1;
        { const int kb = r / 32, nb = r % 32; transpose_item(ap->in[I_W2] + (size_t)l * 4096 * 1024, 4096, 1024, W2, 64 * kb, 32 * nb, 32 * nb, 32, scr, lane); }
    }
}
__device__ __forceinline__ void fold_small(const Frame& F) {
    CArgs* ap = opq_p(F.ap); unsigned char* ws = ap->ws;
    PHASE_UNIFORMS(); const int gt = (vcu * NWAVES + wave) * 64 + opq_v(lane_id()), NT = G * NWAVES * 64;
    float* GW = (float*)(ws + WS_SMALL + SM_GATEW); float* KF = (float*)(ws + WS_SMALL + SM_KFOLD);
    for (int i = gt; i < 2 * 2048 * 8; i += NT) {
        const int j = i / (2048 * 8), ch = (i / 8) % 2048, g = i % 8, n = ch >> 2, d = ch & 3;
        const float* wq = ap->in[I_OD_WQ] + ((size_t)j * 512 + n) * 16 + d * 4; const float* wk = ap->in[I_OD_WK] + ((size_t)j * 512 + n) * 16 + d * 4; const float* wv = ap->in[I_OD_WV] + ((size_t)j * 512 + n) * 16 + d * 4;
        const float* wg = ap->in[I_OD_WGATE] + (size_t)j * 6144 * 8;
        float sc = 0.f, sm = 0.f;
#pragma unroll
        for (int e = 0; e < 4; ++e) { sc += wq[e] * wg[(size_t)(4 * n + e) * 8 + g] + wk[e] * wg[(size_t)(2048 + 4 * n + e) * 8 + g]; sm += wv[e] * wg[(size_t)(4096 + 4 * n + e) * 8 + g]; }
        GW[((size_t)j * 2 + 0) * 2048 * 8 + ch * 8 + g] = sc; GW[((size_t)j * 2 + 1) * 2048 * 8 + ch * 8 + g] = sm;
    }
    for (int i = gt; i < 2 * 512 * 16; i += NT) {
        const int j = i / (512 * 16), n = (i / 16) % 512, ii = (i / 4) % 4, d = i % 4;
        const float* wq = ap->in[I_OD_WQ] + ((size_t)j * 512 + n) * 16 + d * 4; const float* wk = ap->in[I_OD_WK] + ((size_t)j * 512 + n) * 16 + ii * 4;
        float s = 0.f;
#pragma unroll
        for (int e = 0; e < 4; ++e) s += wk[e] * wq[e];
        KF[i] = s * 0.044194173824159216f;
    }
}
__device__ __forceinline__ void x_to_bf16(const Frame& F) {
    CArgs* ap = opq_p(F.ap); unsigned char* ws = ap->ws; const float* x = ap->in[I_X];
    PHASE_UNIFORMS(); const int lane = opq_v(lane_id()); const int gw = vcu * NWAVES + wave, NGW = G * NWAVES; bf16* XB = (bf16*)(ws + WS_XB);
    for (int m = gw; m < M; m += NGW) { const GAS f32x4* xr = (const GAS f32x4*)(x + (size_t)m * DM) + lane; GAS unsigned long long* o8 = (GAS unsigned long long*)(XB + (size_t)m * DM) + lane;
#pragma unroll
        for (int j = 0; j < 4; ++j) { const f32x4 v = xr[64 * j]; o8[64 * j] = (unsigned long long)pk2(v.x, v.y) | ((unsigned long long)pk2(v.z, v.w) << 32); } }
}
__device__ __forceinline__ void ln_phase(const Frame& F, int gi, int bi, int l, bool final_out) {
    CArgs* ap = opq_p(F.ap); unsigned char* ws = ap->ws; const float* T = ap->out; const float* g = ap->in[gi] + (size_t)l * DM; const float* b = ap->in[bi] + (size_t)l * DM; float* OUT = final_out ? ap->out : nullptr;
    PHASE_UNIFORMS(); const int lane = opq_v(lane_id()); const int gw = vcu * NWAVES + wave, NGW = G * NWAVES; bf16* XB = (bf16*)(ws + WS_XB);
    f32x4 gv[4], bv[4];
#pragma unroll
    for (int j = 0; j < 4; ++j) { gv[j] = ((const GAS f32x4*)g)[lane + 64 * j]; bv[j] = ((const GAS f32x4*)b)[lane + 64 * j]; }
    for (int m = gw; m < M; m += NGW) {
        const GAS f32x4* tr = (const GAS f32x4*)(T + (size_t)m * DM) + lane;
        f32x4 v[4]; float s = 0.f;
#pragma unroll
        for (int j = 0; j < 4; ++j) { v[j] = tr[64 * j]; s += (v[j].x + v[j].y) + (v[j].z + v[j].w); }
        const float mean = wave_sum(s, lane) * (1.f / DM); float s2 = 0.f;
#pragma unroll
        for (int j = 0; j < 4; ++j) { v[j] = v[j] - mean; s2 += (v[j].x * v[j].x + v[j].y * v[j].y) + (v[j].z * v[j].z + v[j].w * v[j].w); }
        const float rstd = 1.f / sqrtf(wave_sum(s2, lane) * (1.f / DM) + LN_EPS);
        GAS unsigned long long* o8 = (GAS unsigned long long*)(XB + (size_t)m * DM) + lane;
#pragma unroll
        for (int j = 0; j < 4; ++j) { const f32x4 y = v[j] * rstd * gv[j] + bv[j]; o8[64 * j] = (unsigned long long)pk2(y.x, y.y) | ((unsigned long long)pk2(y.z, y.w) << 32);
            if (OUT) ((GAS f32x4*)(OUT + (size_t)m * DM))[lane + 64 * j] = y; }
    }
}
typedef short v4i16_t __attribute__((ext_vector_type(4)));
__device__ __forceinline__ s16x4 tr4(const LAS unsigned char* p) { return __builtin_bit_cast(s16x4, __builtin_amdgcn_ds_read_tr16_b64_v4i16((LAS v4i16_t*)p)); }
__device__ __forceinline__ bf16x8 tr_frag(const LAS unsigned char* T, int pitch, int k0, int n0, int lane) {
    const int g = lane >> 4, q = (lane & 15) >> 2, p = lane & 3;
    const LAS unsigned char* a = T + (k0 + 8 * g + q) * pitch + (n0 + 4 * p) * 2;
    const s16x4 lo = tr4(a), hi = tr4(a + 4 * pitch);
    return (bf16x8){lo[0], lo[1], lo[2], lo[3], hi[0], hi[1], hi[2], hi[3]};
}
__device__ __forceinline__ void lds_fadd(LAS float* p, float v) { (void)__hip_atomic_fetch_add(p, v, __ATOMIC_RELAXED, __HIP_MEMORY_SCOPE_WORKGROUP); }

__device__ __forceinline__ void o2_conv(const Frame& F, int j) {
    CArgs* ap = opq_p(F.ap); unsigned char* ws = ap->ws; LAS unsigned char* lds = opq_l(lds_base()); PHASE_UNIFORMS();
    const int lane = opq_v(lane_id()), tid = wave * 64 + lane;
    bf16* XM = (bf16*)(ws + WS_BIG); bf16* XC = XM + (size_t)M * MI; bf16* KT = XC + (size_t)M * MI;
    const float* cw = ap->in[I_OD_CONVW] + (size_t)j * 4 * MI; const float* cb = ap->in[I_OD_CONVB] + (size_t)j * MI;
    const float* GW = (const float*)(ws + WS_SMALL + SM_GATEW) + (size_t)j * 2 * MI * 8; const float* KF = (const float*)(ws + WS_SMALL + SM_KFOLD) + (size_t)j * 512 * 16;
    const float* bg = ap->in[I_OD_BGATE] + j * 8;
    float* LI = (float*)(ws + WS_SMALL + SM_LI); float* BC = (float*)(ws + WS_SMALL + SM_BC); float* CHG = (float*)(ws + WS_SMALL + SM_CHG);
    const int n = tid, ch0 = 4 * n, hh = n >> 7, dd0 = 4 * (n & 127);
    float w[4][4], cbv[4], kf[16], gwc[4][8], gwm[4][8];
#pragma unroll
    for (int k = 0; k < 4; ++k)
#pragma unroll
        for (int c = 0; c < 4; ++c) w[k][c] = cw[k * MI + ch0 + c];
#pragma unroll
    for (int c = 0; c < 4; ++c) cbv[c] = cb[ch0 + c];
#pragma unroll
    for (int i = 0; i < 16; ++i) kf[i] = KF[n * 16 + i];
#pragma unroll
    for (int c = 0; c < 4; ++c)
#pragma unroll
        for (int g = 0; g < 8; ++g) { gwc[c][g] = GW[(size_t)(ch0 + c) * 8 + g]; gwm[c][g] = GW[(size_t)(MI + ch0 + c) * 8 + g]; }
    LAS float* part = (LAS float*)lds;
    LAS float* gat = (LAS float*)(lds + LDSX_OFF);
    for (int u = bid; u < BATCH * NCH; u += G) {
        const int b = u >> 6, c = u & 63, t0 = c * MCH; const size_t m0 = (size_t)b * SEQ + t0;
        float p3[4], p2[4], p1[4];
        { uint2 r3 = make_uint2(0u, 0u), r2 = r3, r1 = r3;
          if (c > 0) { r3 = *(const uint2*)(XM + (m0 - 3) * MI + ch0); r2 = *(const uint2*)(XM + (m0 - 2) * MI + ch0); r1 = *(const uint2*)(XM + (m0 - 1) * MI + ch0); }
          p3[0] = bflo(r3.x); p3[1] = bfhi(r3.x); p3[2] = bflo(r3.y); p3[3] = bfhi(r3.y);
          p2[0] = bflo(r2.x); p2[1] = bfhi(r2.x); p2[2] = bflo(r2.y); p2[3] = bfhi(r2.y);
          p1[0] = bflo(r1.x); p1[1] = bfhi(r1.x); p1[2] = bflo(r1.y); p1[3] = bfhi(r1.y); }
        for (int tb = 0; tb < 8; ++tb) {
            uint2 raw[8];
#pragma unroll
            for (int i = 0; i < 8; ++i) raw[i] = *(const uint2*)(XM + (m0 + 8 * tb + i) * MI + ch0);
            unsigned short kp[4][8];
#pragma unroll
            for (int i = 0; i < 8; ++i) {
                float x0[4] = {bflo(raw[i].x), bfhi(raw[i].x), bflo(raw[i].y), bfhi(raw[i].y)}, xc[4];
#pragma unroll
                for (int cc = 0; cc < 4; ++cc) { const float z = w[0][cc] * p3[cc] + w[1][cc] * p2[cc] + w[2][cc] * p1[cc] + w[3][cc] * x0[cc] + cbv[cc]; xc[cc] = z * sigmoidf_(z); }
                *(uint2*)(XC + (m0 + 8 * tb + i) * MI + ch0) = make_uint2(pk2(xc[0], xc[1]), pk2(xc[2], xc[3]));
#pragma unroll
                for (int d = 0; d < 4; ++d) kp[d][i] = (unsigned short)f2bf(xc[0] * kf[0 * 4 + d] + xc[1] * kf[1 * 4 + d] + xc[2] * kf[2 * 4 + d] + xc[3] * kf[3 * 4 + d]);
#pragma unroll
                for (int g = 0; g < 8; ++g) { float s = 0.f;
#pragma unroll
                    for (int cc = 0; cc < 4; ++cc) s += xc[cc] * gwc[cc][g] + x0[cc] * gwm[cc][g];
                    part[(i * 8 + g) * 512 + tid] = s; }
#pragma unroll
                for (int cc = 0; cc < 4; ++cc) { p3[cc] = p2[cc]; p2[cc] = p1[cc]; p1[cc] = x0[cc]; }
            }
#pragma unroll
            for (int d = 0; d < 4; ++d) { v4u o; o.x = kp[d][0] | ((unsigned)kp[d][1] << 16); o.y = kp[d][2] | ((unsigned)kp[d][3] << 16); o.z = kp[d][4] | ((unsigned)kp[d][5] << 16); o.w = kp[d][6] | ((unsigned)kp[d][7] << 16);
                *(v4u*)(KT + ((size_t)((b * MH + hh) * NCH + c) * MDH + dd0 + d) * MCH + 8 * tb) = o; }
            __syncthreads();
#pragma unroll
            for (int pp = 0; pp < 8; ++pp) { const int p = 8 * wave + pp; float s = 0.f;
#pragma unroll
                for (int i = 0; i < 8; ++i) s += part[p * 512 + lane + 64 * i];
                s = wave_sum(s, lane);
                if (lane == 0) gat[(8 * tb + wave) * 8 + pp] = s + bg[pp]; }
            __syncthreads();
        }
        if (tid < 4) { float bc = 0.f, mx = -3.0e38f; const size_t o = (size_t)(b * MH + tid) * SEQ + t0;
            for (int s = 0; s < MCH; ++s) { const float li = gat[s * 8 + tid], lf = logsigmoidf_(gat[s * 8 + 4 + tid]); bc += lf; LI[o + s] = li; BC[o + s] = bc; mx = fmaxf(mx, li - bc); }
            CHG[((size_t)(b * MH + tid) * NCH + c) * 2 + 0] = bc; CHG[((size_t)(b * MH + tid) * NCH + c) * 2 + 1] = bc + mx; }
        __syncthreads();
    }
}

__device__ __forceinline__ void o3_pphase(const Frame& F) {
    CArgs* ap = opq_p(F.ap); unsigned char* ws = ap->ws; LAS unsigned char* lds = opq_l(lds_base()); PHASE_UNIFORMS();
    const int lane = opq_v(lane_id()), tid = wave * 64 + lane, g4 = lane >> 4, l15 = lane & 15;
    const bf16* XC = (const bf16*)(ws + WS_BIG) + (size_t)M * MI; const bf16* KT = XC + (size_t)M * MI;
    bf16* Pg = (bf16*)(ws + WS_AUX);
    const float* LI = (const float*)(ws + WS_SMALL + SM_LI); const float* BC = (const float*)(ws + WS_SMALL + SM_BC); const float* CHG = (const float*)(ws + WS_SMALL + SM_CHG);
    float* WIN_ = (float*)(ws + WS_SMALL + SM_WIN); float* DEN = (float*)(ws + WS_SMALL + SM_DEN); float* EMM = (float*)(ws + WS_SMALL + SM_EMM); float* WK = (float*)(ws + WS_SMALL + SM_WK); float* DEC = (float*)(ws + WS_SMALL + SM_DEC);
    LAS unsigned char* KL = lds;
    LAS float* sbt = (LAS float*)(lds + 80 * 1024); LAS float* sli = sbt + 64; LAS float* smt = sbt + 128; LAS float* sden = sbt + 192;
    for (int u = vcu; u < BATCH * MH * NCH; u += G) {
        const int bh = u >> 6, c = u & 63, b = bh >> 2, h = bh & 3; const size_t m0 = (size_t)b * SEQ + c * MCH;
        { const bf16* src = KT + (size_t)u * MDH * MCH;
#pragma unroll
          for (int i = 0; i < 8; ++i) { const int p = tid + 512 * i, row = p >> 3, c16 = p & 7; *(LAS v4u*)(KL + row * 144 + c16 * 16) = *(const v4u*)(src + row * 64 + c16 * 8); } }
        if (wave == 0) {
            const float gi = CHG[((size_t)bh * NCH + lane) * 2 + 0], ai = CHG[((size_t)bh * NCH + lane) * 2 + 1];
            float m = 0.f;
            for (int i = 0; i < c; ++i) { const float g_ = shi(gi, i), a_ = shi(ai, i); m = fmaxf(g_ + m, a_); }
            const float bt = BC[(size_t)bh * SEQ + c * MCH + lane], li = LI[(size_t)bh * SEQ + c * MCH + lane];
            float pm = li - bt;
#pragma unroll
            for (int o = 1; o < 64; o <<= 1) { const float v = shi(pm, lane >= o ? lane - o : lane); if (lane >= o) pm = fmaxf(pm, v); }
            const float mt = bt + fmaxf(m, pm);
            const float g = shi(bt, 63), pm63 = shi(pm, 63), mnew = g + fmaxf(m, pm63);
            const size_t o = (size_t)bh * SEQ + c * MCH + lane;
            WIN_[o] = __expf(bt + m - mt); EMM[o] = __expf(-mt); WK[o] = __expf(g - bt + li - mnew);
            if (lane == 0) DEC[bh * NCH + c] = __expf(g + m - mnew);
            sbt[lane] = bt; sli[lane] = li; smt[lane] = mt;
        }
        __syncthreads();
        const int mb = wave >> 1;
        f32x4 acc[2] = {(f32x4){0.f, 0.f, 0.f, 0.f}, (f32x4){0.f, 0.f, 0.f, 0.f}};
        const bf16* qrow = XC + (m0 + 16 * mb + l15) * MI + h * MDH + 8 * g4;
        for (int ks = 0; ks < 16; ++ks) {
            const bf16x8 A = *(const bf16x8*)(qrow + 32 * ks);
#pragma unroll
            for (int nn = 0; nn < 2; ++nn) { const int nb = 2 * (wave & 1) + nn;
                if (nb <= mb) { const bf16x8 B = tr_frag(KL, 144, 32 * ks, 16 * nb, lane); acc[nn] = MFMA16(A, B, acc[nn]); } }
        }
        float rs[4] = {0.f, 0.f, 0.f, 0.f};
#pragma unroll
        for (int nn = 0; nn < 2; ++nn) { const int nb = 2 * (wave & 1) + nn, s = 16 * nb + l15; const float bs = sbt[s], ls = sli[s];
#pragma unroll
            for (int i = 0; i < 4; ++i) { const int t = 16 * mb + 4 * g4 + i; float p = 0.f;
                if (nb <= mb && s <= t) p = __expf(sbt[t] - bs + ls - smt[t]) * acc[nn][i];
                rs[i] += p; Pg[((size_t)u * 64 + t) * 64 + s] = (bf16)f2bf(p); } }
#pragma unroll
        for (int i = 0; i < 4; ++i) { float r = rs[i]; r += shx(r, 1, lane); r += shx(r, 2, lane); r += shx(r, 4, lane); r += shx(r, 8, lane);
            if (l15 == 0) sden[(wave & 1) * 64 + 16 * mb + 4 * g4 + i] = r; }
        __syncthreads();
        if (tid < 64) DEN[(size_t)bh * SEQ + c * MCH + tid] = sden[tid] + sden[64 + tid];
        __syncthreads();
    }
}

__device__ __forceinline__ void o4_scan(const Frame& F, int j) {
    CArgs* ap = opq_p(F.ap); unsigned char* ws = ap->ws; LAS unsigned char* lds = opq_l(lds_base()); PHASE_UNIFORMS();
    const int lane = opq_v(lane_id()), tid = wave * 64 + lane, g4 = lane >> 4, l15 = lane & 15;
    bf16* XM = (bf16*)(ws + WS_BIG); const bf16* XC = XM + (size_t)M * MI; const bf16* KT = XC + (size_t)M * MI;
    const bf16* Pg = (const bf16*)(ws + WS_AUX); const bf16* OG = (const bf16*)ap->out;
    const float* WIN_ = (const float*)(ws + WS_SMALL + SM_WIN); const float* DEN = (const float*)(ws + WS_SMALL + SM_DEN); const float* EMM = (const float*)(ws + WS_SMALL + SM_EMM);
    const float* WK = (const float*)(ws + WS_SMALL + SM_WK); const float* DEC = (const float*)(ws + WS_SMALL + SM_DEC);
    const float* wvp = ap->in[I_OD_WV] + (size_t)j * 512 * 16;
    LAS unsigned char* Vl = lds;
    LAS unsigned char* VTl = lds + 9216;
    LAS unsigned char* Pl = lds + 20480;
    LAS unsigned char* Ct = lds + 29696;
    LAS float* swin = (LAS float*)(lds + 29696 + 83200); LAS float* sden = swin + 64; LAS float* semm = swin + 128; LAS float* sqn = swin + 192;
    constexpr int CP = 1040;
    for (int u = vcu; u < BATCH * MH * 8; u += G) {
        const int bh = u >> 3, es = u & 7, b = bh >> 2, h = bh & 3, col0 = h * MDH + es * 64;
        f32x4 Cacc[4][5];
#pragma unroll
        for (int db = 0; db < 4; ++db)
#pragma unroll
            for (int nb = 0; nb < 5; ++nb) Cacc[db][nb] = (f32x4){0.f, 0.f, 0.f, 0.f};
        const int vs = tid >> 3, ve0 = 8 * (tid & 7);
        const int mb = wave >> 1, nb0 = 2 * (wave & 1); const bool has_n = (wave & 1) == 0;
        for (int c = 0; c < NCH; ++c) {
            const size_t m0 = (size_t)b * SEQ + c * MCH; const size_t so = (size_t)bh * SEQ + c * MCH;
            { const v4u xr = *(const v4u*)(XM + (m0 + vs) * MI + col0 + ve0); const float wks = WK[so + vs];
              float x[8] = {bflo(xr.x), bfhi(xr.x), bflo(xr.y), bfhi(xr.y), bflo(xr.z), bfhi(xr.z), bflo(xr.w), bfhi(xr.w)}, v[8];
#pragma unroll
              for (int blk = 0; blk < 2; ++blk) { const float* wv = wvp + (size_t)((col0 + ve0) / 4 + blk) * 16;
#pragma unroll
                  for (int e = 0; e < 4; ++e) v[4 * blk + e] = x[4 * blk + 0] * wv[0 * 4 + e] + x[4 * blk + 1] * wv[1 * 4 + e] + x[4 * blk + 2] * wv[2 * 4 + e] + x[4 * blk + 3] * wv[3 * 4 + e]; }
              v4u o; o.x = pk2(v[0], v[1]); o.y = pk2(v[2], v[3]); o.z = pk2(v[4], v[5]); o.w = pk2(v[6], v[7]);
              *(LAS v4u*)(Vl + vs * 144 + ve0 * 2) = o;
              o.x = pk2(wks * v[0], wks * v[1]); o.y = pk2(wks * v[2], wks * v[3]); o.z = pk2(wks * v[4], wks * v[5]); o.w = pk2(wks * v[6], wks * v[7]);
              *(LAS v4u*)(VTl + vs * 176 + ve0 * 2) = o;
              if ((tid & 7) == 0) { v4u z; z.x = f2bf(wks); z.y = 0u; z.z = 0u; z.w = 0u; *(LAS v4u*)(VTl + vs * 176 + 128) = z; z.x = 0u; *(LAS v4u*)(VTl + vs * 176 + 144) = z; }
              *(LAS v4u*)(Pl + vs * 144 + ve0 * 2) = *(const v4u*)(Pg + ((size_t)(bh * NCH + c) * 64 + vs) * 64 + ve0);
              if (tid < 64) { swin[tid] = WIN_[so + tid]; sden[tid] = DEN[so + tid]; semm[tid] = EMM[so + tid]; } }
#pragma unroll
            for (int db = 0; db < 4; ++db)
#pragma unroll
                for (int nb = 0; nb < 5; ++nb) *(LAS v2u*)(Ct + (16 * nb + l15) * CP + (wave * 64 + 16 * db + 4 * g4) * 2) = (v2u){pk2(Cacc[db][nb][0], Cacc[db][nb][1]), pk2(Cacc[db][nb][2], Cacc[db][nb][3])};
            const float decay = DEC[bh * NCH + c];
            bf16x8 qf[16];
#pragma unroll
            for (int ks = 0; ks < 16; ++ks) qf[ks] = *(const bf16x8*)(XC + (m0 + 16 * mb + l15) * MI + h * MDH + 32 * ks + 8 * g4);
            __syncthreads();
            f32x4 acc[2] = {(f32x4){0.f, 0.f, 0.f, 0.f}, (f32x4){0.f, 0.f, 0.f, 0.f}}, accn = (f32x4){0.f, 0.f, 0.f, 0.f};
#pragma unroll
            for (int ks = 0; ks < 16; ++ks) {
#pragma unroll
                for (int nn = 0; nn < 2; ++nn) { const bf16x8 B = *(const LAS bf16x8*)(Ct + (16 * (nb0 + nn) + l15) * CP + (32 * ks + 8 * g4) * 2); acc[nn] = MFMA16(qf[ks], B, acc[nn]); }
                if (has_n) { const bf16x8 B = *(const LAS bf16x8*)(Ct + (64 + l15) * CP + (32 * ks + 8 * g4) * 2); accn = MFMA16(qf[ks], B, accn); } }
            float wi[4];
#pragma unroll
            for (int i = 0; i < 4; ++i) wi[i] = swin[16 * mb + 4 * g4 + i];
#pragma unroll
            for (int nn = 0; nn < 2; ++nn)
#pragma unroll
                for (int i = 0; i < 4; ++i) acc[nn][i] *= wi[i];
            if (has_n && l15 == 0) {
#pragma unroll
                for (int i = 0; i < 4; ++i) sqn[16 * mb + 4 * g4 + i] = wi[i] * accn[i]; }
#pragma unroll
            for (int ks = 0; ks < 2; ++ks) { const bf16x8 A = *(const LAS bf16x8*)(Pl + (16 * mb + l15) * 144 + (32 * ks + 8 * g4) * 2);
#pragma unroll
                for (int nn = 0; nn < 2; ++nn) { const bf16x8 B = tr_frag(Vl, 144, 32 * ks, 16 * (nb0 + nn), lane); acc[nn] = MFMA16(A, B, acc[nn]); } }
            bf16x8 kf[4][2];
#pragma unroll
            for (int db = 0; db < 4; ++db)
#pragma unroll
                for (int ks = 0; ks < 2; ++ks) kf[db][ks] = *(const bf16x8*)(KT + ((size_t)(bh * NCH + c) * MDH + wave * 64 + 16 * db + l15) * MCH + 32 * ks + 8 * g4);
            __syncthreads();
#pragma unroll
            for (int i = 0; i < 4; ++i) { const int t = 16 * mb + 4 * g4 + i; const float dn = sqn[t] + sden[t], rd = 1.0f / fmaxf(fabsf(dn), semm[t]);
#pragma unroll
                for (int nn = 0; nn < 2; ++nn) { const size_t o = (m0 + t) * MI + col0 + 16 * (nb0 + nn) + l15; XM[o] = (bf16)f2bf(acc[nn][i] * rd * bf2f(OG[o])); } }
#pragma unroll
            for (int db = 0; db < 4; ++db)
#pragma unroll
                for (int nb = 0; nb < 5; ++nb) Cacc[db][nb] = Cacc[db][nb] * decay;
#pragma unroll
            for (int nb = 0; nb < 5; ++nb)
#pragma unroll
                for (int ks = 0; ks < 2; ++ks) { const bf16x8 B = tr_frag(VTl, 176, 32 * ks, 16 * nb, lane);
#pragma unroll
                    for (int db = 0; db < 4; ++db) Cacc[db][nb] = MFMA16(kf[db][ks], B, Cacc[db][nb]); }
            __syncthreads();
        }
    }
}

__device__ __forceinline__ void o5_norm(const Frame& F, int j) {
    CArgs* ap = opq_p(F.ap); unsigned char* ws = ap->ws; PHASE_UNIFORMS(); const int lane = opq_v(lane_id()); const int gw = vcu * NWAVES + wave, NGW = G * NWAVES;
    bf16* HB = (bf16*)(ws + WS_BIG); const bf16* XC = HB + (size_t)M * MI;
    const float* ng = ap->in[I_OD_NORM] + (size_t)j * MI; const float* sk = ap->in[I_OD_SKIP] + (size_t)j * MI;
    for (int idx = gw; idx < M * MH; idx += NGW) {
        const int m = idx >> 2, h = idx & 3; const size_t o = (size_t)m * MI + h * MDH + 8 * lane;
        const v4u hr = *(const v4u*)(HB + o), xr = *(const v4u*)(XC + o);
        float v[8] = {bflo(hr.x), bfhi(hr.x), bflo(hr.y), bfhi(hr.y), bflo(hr.z), bfhi(hr.z), bflo(hr.w), bfhi(hr.w)};
        const float x[8] = {bflo(xr.x), bfhi(xr.x), bflo(xr.y), bfhi(xr.y), bflo(xr.z), bfhi(xr.z), bflo(xr.w), bfhi(xr.w)};
        float s = 0.f;
#pragma unroll
        for (int e = 0; e < 8; ++e) s += v[e];
        const float mean = wave_sum(s, lane) * (1.f / MDH); float s2 = 0.f;
#pragma unroll
        for (int e = 0; e < 8; ++e) { v[e] -= mean; s2 += v[e] * v[e]; }
        const float rstd = 1.f / sqrtf(wave_sum(s2, lane) * (1.f / MDH) + LN_EPS);
        const f32x4 g0 = *(const f32x4*)(ng + h * MDH + 8 * lane), g1 = *(const f32x4*)(ng + h * MDH + 8 * lane + 4), k0 = *(const f32x4*)(sk + h * MDH + 8 * lane), k1 = *(const f32x4*)(sk + h * MDH + 8 * lane + 4);
        float y[8];
#pragma unroll
        for (int e = 0; e < 4; ++e) { y[e] = v[e] * rstd * g0[e] + k0[e] * x[e]; y[4 + e] = v[4 + e] * rstd * g1[e] + k1[e] * x[4 + e]; }
        v4u ov; ov.x = pk2(y[0], y[1]); ov.y = pk2(y[2], y[3]); ov.z = pk2(y[4], y[5]); ov.w = pk2(y[6], y[7]);
        *(v4u*)(HB + o) = ov;
    }
}

__device__ __forceinline__ void odd_mixer(const Frame& F, int j, const XcdBarrier& bar) {
    o2_conv(F, j);
    xcd_barrier(bar, F.wave);
    o3_pphase(F);
    xcd_barrier(bar, F.wave);
    o4_scan(F, j);
    xcd_barrier(bar, F.wave);
    o5_norm(F, j);
    xcd_barrier(bar, F.wave);
}
constexpr size_t EV_LT_OFF = (size_t)M * EVW * 2;
constexpr size_t SM_GD = 9 * MiB;

__device__ __forceinline__ unsigned mono_key(float f) { const unsigned u = __float_as_uint(f); return (u & 0x80000000u) ? ~u : (u | 0x80000000u); }

__device__ __forceinline__ void e2_index_topk(const Frame& F) {
    CArgs* ap = opq_p(F.ap); unsigned char* ws = ap->ws; LAS unsigned char* lds = opq_l(lds_base()); PHASE_UNIFORMS();
    const int lane = opq_v(lane_id()), tid = wave * 64 + lane, l31 = lane & 31, hi = lane >> 5;
    const bf16* EV = (const bf16*)(ws + WS_BIG);
    unsigned long long* BMK = (unsigned long long*)(ws + WS_AUX);
    LAS float* sc = (LAS float*)lds;
        for (int i = bid; i < BATCH * 512; i += G) {
        const int r = i / G, w = i % G;
        int b, qt;
        if (G == 256) { b = r >> 1; qt = (r & 1) ? 511 - w : w; } else { b = i >> 9; qt = i & 511; }
        const int p0 = qt * 8; const size_t mb0 = (size_t)b * SEQ;
        const int nkt = (p0 + 8 + 31) >> 5, lim = nkt * 32;
        bf16x8 Af[2][4]; float wq[2][2][8];
        { const int jj = l31 >> 3, hp = (l31 >> 2) & 1, ii = l31 & 3, ql = (jj >> 1) + 2 * hp, head = 4 * (jj & 1) + ii;
#pragma unroll
          for (int mb = 0; mb < 2; ++mb) { const bf16* qp = EV + (mb0 + p0 + 4 * mb + ql) * EVW + EC_IQ + head * 64 + 8 * hi;
#pragma unroll
              for (int ks = 0; ks < 4; ++ks) Af[mb][ks] = *(const bf16x8*)(qp + 16 * ks);
#pragma unroll
              for (int qq = 0; qq < 2; ++qq) { const v4u wr = *(const v4u*)(EV + (mb0 + p0 + 4 * mb + 2 * hi + qq) * EVW + EC_IW);
                  wq[mb][qq][0] = bflo(wr.x); wq[mb][qq][1] = bfhi(wr.x); wq[mb][qq][2] = bflo(wr.y); wq[mb][qq][3] = bfhi(wr.y);
                  wq[mb][qq][4] = bflo(wr.z); wq[mb][qq][5] = bfhi(wr.z); wq[mb][qq][6] = bflo(wr.w); wq[mb][qq][7] = bfhi(wr.w); } } }
        for (int kt = wave; kt < nkt; kt += NWAVES) {
            const int key = 32 * kt + l31; const bf16* kp = EV + (mb0 + key) * EVW + EC_IK + 8 * hi;
            bf16x8 Bf[4];
#pragma unroll
            for (int ks = 0; ks < 4; ++ks) Bf[ks] = *(const bf16x8*)(kp + 16 * ks);
#pragma unroll
            for (int mb = 0; mb < 2; ++mb) { f32x16 acc;
#pragma unroll
                for (int e = 0; e < 16; ++e) acc[e] = 0.f;
#pragma unroll
                for (int ks = 0; ks < 4; ++ks) acc = MFMA32(Af[mb][ks], Bf[ks], acc);
#pragma unroll
                for (int qq = 0; qq < 2; ++qq) { float s = 0.f;
#pragma unroll
                    for (int h = 0; h < 8; ++h) s += wq[mb][qq][h] * fmaxf(acc[8 * qq + h], 0.f);
                    const int ql = 4 * mb + 2 * hi + qq;
                    sc[ql * 4096 + key] = (key <= p0 + ql) ? s : -__builtin_inff(); } }
        }
        __syncthreads();
        const int qpos = p0 + wave, n = qpos + 1;
        unsigned keys[64];
#pragma unroll
        for (int j = 0; j < 64; ++j) { const int idx = 64 * j + lane; keys[j] = (idx < lim) ? mono_key(sc[wave * 4096 + idx]) : 0u; }
        __syncthreads();
        unsigned long long myword = 0ull;
        if (n <= 256) {
            const int idx0 = 64 * lane;
            const int cnt = n - idx0; myword = cnt >= 64 ? ~0ull : (cnt <= 0 ? 0ull : ((1ull << cnt) - 1ull));
        } else {
            unsigned T = 0u;
            for (int bit = 31; bit >= 0; --bit) { const unsigned cand = T | (1u << bit); int cnt = 0;
#pragma unroll
                for (int j = 0; j < 64; ++j) cnt += __popcll(__ballot(keys[j] >= cand));
                if (cnt >= 256) T = cand;
                if (cnt == 256) break; }
            int cgt = 0;
#pragma unroll
            for (int j = 0; j < 64; ++j) cgt += __popcll(__ballot(keys[j] > T));
            int need = 256 - cgt;
#pragma unroll
            for (int j = 0; j < 64; ++j) { const unsigned long long gt = __ballot(keys[j] > T), eq = __ballot(keys[j] == T); unsigned long long keep = eq;
                const int eqc = __popcll(eq); int take = need < eqc ? need : eqc; if (take < 0) take = 0;
                if (take < eqc) { keep = 0ull; unsigned long long mm = eq; for (int k = 0; k < take; ++k) { const unsigned long long low = mm & (0ull - mm); keep |= low; mm ^= low; } }
                need -= take;
                const unsigned long long word = gt | keep;
                if (lane == j) myword = word; }
        }
        BMK[(mb0 + qpos) * 64 + lane] = myword;
    }
}

__device__ __forceinline__ void e3_attention(const Frame& F) {
    CArgs* ap = opq_p(F.ap); unsigned char* ws = ap->ws; LAS unsigned char* lds = opq_l(lds_base()); PHASE_UNIFORMS();
    const int lane = opq_v(lane_id()), tid = wave * 64 + lane, l31 = lane & 31, hi = lane >> 5;
    bf16* EV = (bf16*)(ws + WS_BIG);
    const unsigned long long* BMK = (const unsigned long long*)(ws + WS_AUX);
    LAS unsigned char* Kl = lds;
    LAS unsigned char* Vt = lds + 9216;
        constexpr float SC2 = 0.125f * 1.4426950408889634f;
    for (int i = bid; i < BATCH * 128; i += G) {
        int b, qt;
        if (G == 256) { const int k = i >> 8, w = i & 255; b = 2 * k + (w >> 7); qt = (k & 1) ? 127 - (w & 127) : (w & 127); } else { b = i >> 7; qt = i & 127; }
        const size_t mb0 = (size_t)b * SEQ; const int q0 = qt * 32, nkt = (qt >> 1) + 1;
        const int ql = l31 >> 3, head = l31 & 7, qpos = q0 + 4 * wave + ql;
        bf16* qrow = EV + (mb0 + qpos) * EVW + EC_AQ + head * 64;
        bf16x8 Qf[4];
#pragma unroll
        for (int ks = 0; ks < 4; ++ks) Qf[ks] = *(const bf16x8*)(qrow + 16 * ks + 8 * hi);
        f32x16 accO[2];
#pragma unroll
        for (int e = 0; e < 16; ++e) { accO[0][e] = 0.f; accO[1][e] = 0.f; }
        float mrun = -__builtin_inff(), lrun = 0.f;
        const int skey = tid >> 3, spc = tid & 7;
        const int kk = skey & 31, vpos = (skey & 32) + 16 * (kk >> 4) + 8 * ((kk >> 2) & 1) + 4 * ((kk >> 3) & 1) + (kk & 3);
        v4u kreg = *(const v4u*)(EV + (mb0 + skey) * EVW + EC_AK + 8 * spc), vreg = *(const v4u*)(EV + (mb0 + skey) * EVW + EC_AV + 8 * spc);
        unsigned long long mword = BMK[(mb0 + qpos) * 64 + 0];
        for (int kt = 0; kt < nkt; ++kt) {
            __syncthreads();
            *(LAS v4u*)(Kl + skey * 144 + spc * 16) = kreg;
            { LAS unsigned short* vp = (LAS unsigned short*)(Vt + (8 * spc) * 144 + vpos * 2);
              vp[0 * 72] = (unsigned short)(vreg.x & 0xffffu); vp[1 * 72] = (unsigned short)(vreg.x >> 16); vp[2 * 72] = (unsigned short)(vreg.y & 0xffffu); vp[3 * 72] = (unsigned short)(vreg.y >> 16);
              vp[4 * 72] = (unsigned short)(vreg.z & 0xffffu); vp[5 * 72] = (unsigned short)(vreg.z >> 16); vp[6 * 72] = (unsigned short)(vreg.w & 0xffffu); vp[7 * 72] = (unsigned short)(vreg.w >> 16); }
            const unsigned long long mw = mword;
            __syncthreads();
            if (kt + 1 < nkt) { const size_t kr = mb0 + 64 * (kt + 1) + skey; kreg = *(const v4u*)(EV + kr * EVW + EC_AK + 8 * spc); vreg = *(const v4u*)(EV + kr * EVW + EC_AV + 8 * spc); mword = BMK[(mb0 + qpos) * 64 + kt + 1]; }
            f32x16 accS[2];
#pragma unroll
            for (int kb = 0; kb < 2; ++kb) {
#pragma unroll
                for (int e = 0; e < 16; ++e) accS[kb][e] = 0.f;
#pragma unroll
                for (int ks = 0; ks < 4; ++ks) { const bf16x8 Kf = *(const LAS bf16x8*)(Kl + (32 * kb + l31) * 144 + (16 * ks + 8 * hi) * 2); accS[kb] = MFMA32(Kf, Qf[ks], accS[kb]); } }
            float mloc = -__builtin_inff();
#pragma unroll
            for (int kb = 0; kb < 2; ++kb)
#pragma unroll
                for (int e = 0; e < 16; ++e) { const int kin = 32 * kb + (e & 3) + 8 * (e >> 2) + 4 * hi; const bool sel = (mw >> kin) & 1ull;
                    const float x = sel ? accS[kb][e] * SC2 : -__builtin_inff(); accS[kb][e] = x; mloc = fmaxf(mloc, x); }
            mloc = fmaxf(mloc, shx(mloc, 32, lane));
            const float mnew = fmaxf(mrun, mloc), muse = (mnew == -__builtin_inff()) ? 0.f : mnew;
            const float alpha = exp2f(mrun - muse);
            mrun = mnew;
            float lsum = 0.f;
            bf16x8 Pf[2][2];
#pragma unroll
            for (int kb = 0; kb < 2; ++kb) { float p[16];
#pragma unroll
                for (int e = 0; e < 16; ++e) { p[e] = exp2f(accS[kb][e] - muse); lsum += p[e]; }
#pragma unroll
                for (int s = 0; s < 2; ++s) { v4u t; t.x = pk2(p[8 * s + 0], p[8 * s + 1]); t.y = pk2(p[8 * s + 2], p[8 * s + 3]); t.z = pk2(p[8 * s + 4], p[8 * s + 5]); t.w = pk2(p[8 * s + 6], p[8 * s + 7]); Pf[kb][s] = __builtin_bit_cast(bf16x8, t); } }
            lrun = lrun * alpha + lsum;
#pragma unroll
            for (int db = 0; db < 2; ++db) {
#pragma unroll
                for (int e = 0; e < 16; ++e) accO[db][e] *= alpha;
#pragma unroll
                for (int kb = 0; kb < 2; ++kb)
#pragma unroll
                    for (int s = 0; s < 2; ++s) { const bf16x8 Vf = *(const LAS bf16x8*)(Vt + (32 * db + l31) * 144 + (32 * kb + 16 * s + 8 * hi) * 2); accO[db] = MFMA32(Vf, Pf[kb][s], accO[db]); } }
        }
        const float ltot = lrun + shx(lrun, 32, lane), rl = 1.0f / ltot;
#pragma unroll
        for (int db = 0; db < 2; ++db)
#pragma unroll
            for (int g = 0; g < 4; ++g) { const int d = 32 * db + 8 * g + 4 * hi;
                *(uint2*)(qrow + d) = make_uint2(pk2(accO[db][4 * g + 0] * rl, accO[db][4 * g + 1] * rl), pk2(accO[db][4 * g + 2] * rl, accO[db][4 * g + 3] * rl)); }
    }
}

__device__ __forceinline__ void g1_gla_local(const Frame& F, int j) {
    CArgs* ap = opq_p(F.ap); unsigned char* ws = ap->ws; LAS unsigned char* lds = opq_l(lds_base()); PHASE_UNIFORMS();
    const int lane = opq_v(lane_id()), tid = wave * 64 + lane, g4 = lane >> 4, l15 = lane & 15;
    bf16* EV = (bf16*)(ws + WS_BIG);
    float* LT = (float*)(ws + WS_BIG + EV_LT_OFF); float* GD = (float*)(ws + WS_SMALL + SM_GD);
    const float* w2 = ap->in[I_EV_GW2] + (size_t)j * 16 * 512; const float* b2 = ap->in[I_EV_GB2] + (size_t)j * 512;
    LAS float* la = (LAS float*)lds;
    LAS unsigned char* Qt = lds + 32768;
    LAS unsigned char* Kt = Qt + 17408; LAS unsigned char* KE = Kt + 17408; LAS unsigned char* Vl = KE + 17408;
    LAS unsigned char* Pl = Vl + 17408;
    LAS float* w2l = (LAS float*)(Pl + 9216);
    for (int u = vcu; u < BATCH * 4 * 64; u += G) {
        const int bh = u >> 6, c = u & 63, b = bh >> 2, h = bh & 3; const size_t m0 = (size_t)b * SEQ + c * 64;
        for (int i = tid; i < 17 * 128; i += 512) w2l[i] = (i < 2048) ? w2[(size_t)(i >> 7) * 512 + h * 128 + (i & 127)] : b2[h * 128 + (i & 127)];
        __syncthreads();
        const int t = tid >> 3, d0 = 16 * (tid & 7);
        { const v4u r0 = *(const v4u*)(EV + (m0 + t) * EVW + EC_GLR), r1 = *(const v4u*)(EV + (m0 + t) * EVW + EC_GLR + 8);
          const float gl[16] = {bflo(r0.x), bfhi(r0.x), bflo(r0.y), bfhi(r0.y), bflo(r0.z), bfhi(r0.z), bflo(r0.w), bfhi(r0.w), bflo(r1.x), bfhi(r1.x), bflo(r1.y), bfhi(r1.y), bflo(r1.z), bfhi(r1.z), bflo(r1.w), bfhi(r1.w)};
#pragma unroll
          for (int dd = 0; dd < 16; ++dd) { float z = w2l[2048 + d0 + dd];
#pragma unroll
              for (int r = 0; r < 16; ++r) z += gl[r] * w2l[r * 128 + d0 + dd];
              la[t * 128 + d0 + dd] = logsigmoidf_(z) * (1.0f / 16.0f); } }
        __syncthreads();
        { const int d = tid & 127, seg = tid >> 7; float run = 0.f;
#pragma unroll
          for (int s = 0; s < 16; ++s) { run += la[(16 * seg + s) * 128 + d]; la[(16 * seg + s) * 128 + d] = run; }
          __syncthreads();
          float off = 0.f;
          for (int s2 = 0; s2 < seg; ++s2) off += la[(16 * s2 + 15) * 128 + d];
          __syncthreads();
#pragma unroll
          for (int s = 0; s < 16; ++s) la[(16 * seg + s) * 128 + d] += off; }
        __syncthreads();
        { bf16* qg = EV + (m0 + t) * EVW + EC_GQ + h * 128 + d0; const bf16* kg = EV + (m0 + t) * EVW + EC_GK + h * 128 + d0; const bf16* vg = EV + (m0 + t) * EVW + EC_GV + h * 128 + d0;
#pragma unroll
          for (int hf = 0; hf < 2; ++hf) { const v4u qr = *(const v4u*)(qg + 8 * hf), kr = *(const v4u*)(kg + 8 * hf), vr = *(const v4u*)(vg + 8 * hf);
              const float qv[8] = {bflo(qr.x), bfhi(qr.x), bflo(qr.y), bfhi(qr.y), bflo(qr.z), bfhi(qr.z), bflo(qr.w), bfhi(qr.w)};
              const float kv[8] = {bflo(kr.x), bfhi(kr.x), bflo(kr.y), bfhi(kr.y), bflo(kr.z), bfhi(kr.z), bflo(kr.w), bfhi(kr.w)};
              float qt_[8], kt_[8], ke_[8];
#pragma unroll
              for (int e = 0; e < 8; ++e) { const int d = d0 + 8 * hf + e; const float bc = la[t * 128 + d], gd = la[63 * 128 + d];
                  qt_[e] = qv[e] * __expf(bc) * 0.08838834764831845f; kt_[e] = kv[e] * __expf(-bc); ke_[e] = kv[e] * __expf(gd - bc);
                  if (t == 63) GD[((size_t)bh * 64 + c) * 128 + d] = __expf(gd); }
              v4u o; o.x = pk2(qt_[0], qt_[1]); o.y = pk2(qt_[2], qt_[3]); o.z = pk2(qt_[4], qt_[5]); o.w = pk2(qt_[6], qt_[7]);
              *(LAS v4u*)(Qt + t * 272 + (d0 + 8 * hf) * 2) = o; *(v4u*)(qg + 8 * hf) = o;
              o.x = pk2(kt_[0], kt_[1]); o.y = pk2(kt_[2], kt_[3]); o.z = pk2(kt_[4], kt_[5]); o.w = pk2(kt_[6], kt_[7]); *(LAS v4u*)(Kt + t * 272 + (d0 + 8 * hf) * 2) = o;
              o.x = pk2(ke_[0], ke_[1]); o.y = pk2(ke_[2], ke_[3]); o.z = pk2(ke_[4], ke_[5]); o.w = pk2(ke_[6], ke_[7]); *(LAS v4u*)(KE + t * 272 + (d0 + 8 * hf) * 2) = o;
              *(LAS v4u*)(Vl + t * 272 + (d0 + 8 * hf) * 2) = vr; } }
        __syncthreads();
        { const int mb = wave >> 1;
#pragma unroll
          for (int nn = 0; nn < 2; ++nn) { const int nb = 2 * (wave & 1) + nn; f32x4 acc = (f32x4){0.f, 0.f, 0.f, 0.f};
              if (nb <= mb) {
#pragma unroll
                  for (int ks = 0; ks < 4; ++ks) { const bf16x8 A = *(const LAS bf16x8*)(Qt + (16 * mb + l15) * 272 + (32 * ks + 8 * g4) * 2), B = *(const LAS bf16x8*)(Kt + (16 * nb + l15) * 272 + (32 * ks + 8 * g4) * 2); acc = MFMA16(A, B, acc); } }
#pragma unroll
              for (int i = 0; i < 4; ++i) { const int tt = 16 * mb + 4 * g4 + i, s = 16 * nb + l15; *(LAS unsigned short*)(Pl + tt * 144 + s * 2) = (unsigned short)f2bf((nb <= mb && s <= tt) ? acc[i] : 0.f); } } }
        __syncthreads();
        { const int mb = wave >> 1;
#pragma unroll
          for (int nn = 0; nn < 4; ++nn) { const int nb = 4 * (wave & 1) + nn; f32x4 acc = (f32x4){0.f, 0.f, 0.f, 0.f};
#pragma unroll
              for (int ks = 0; ks < 2; ++ks) { const bf16x8 A = *(const LAS bf16x8*)(Pl + (16 * mb + l15) * 144 + (32 * ks + 8 * g4) * 2); const bf16x8 B = tr_frag(Vl, 272, 32 * ks, 16 * nb, lane); acc = MFMA16(A, B, acc); }
#pragma unroll
              for (int i = 0; i < 4; ++i) EV[(m0 + 16 * mb + 4 * g4 + i) * EVW + EC_GK + h * 128 + 16 * nb + l15] = (bf16)f2bf(acc[i]); }
          float* lt = LT + (size_t)u * 128 * 128;
#pragma unroll
          for (int nb = 0; nb < 8; ++nb) { f32x4 acc = (f32x4){0.f, 0.f, 0.f, 0.f};
#pragma unroll
              for (int ks = 0; ks < 2; ++ks) { const bf16x8 A = tr_frag(KE, 272, 32 * ks, 16 * wave, lane), B = tr_frag(Vl, 272, 32 * ks, 16 * nb, lane); acc = MFMA16(A, B, acc); }
              *(f32x4*)(lt + (size_t)(16 * nb + l15) * 128 + 16 * wave + 4 * g4) = acc; } }
        __syncthreads();
    }
}
__device__ __forceinline__ void g2_gla_scan(const Frame& F) {
    CArgs* ap = opq_p(F.ap); unsigned char* ws = ap->ws; PHASE_UNIFORMS(); const int tid = wave * 64 + opq_v(lane_id());
    float* LT = (float*)(ws + WS_BIG + EV_LT_OFF); const float* GD = (const float*)(ws + WS_SMALL + SM_GD);
    for (int e4 = vcu * 512 + tid; e4 < BATCH * 4 * 4096; e4 += G * 512) {
        const int bh = e4 >> 12, r = e4 & 4095, dk0 = 4 * (r & 31);
        f32x4 S = (f32x4){0.f, 0.f, 0.f, 0.f};
        for (int c = 0; c < 64; ++c) { f32x4* p = (f32x4*)(LT + ((size_t)(bh * 64 + c) * 4096 + r) * 4); const f32x4 L = *p; const f32x4 g = *(const f32x4*)(GD + ((size_t)bh * 64 + c) * 128 + dk0);
            *p = S; S = g * S + L; }
    }
}
__device__ __forceinline__ void g3_gla_out(const Frame& F, int j) {
    CArgs* ap = opq_p(F.ap); unsigned char* ws = ap->ws; LAS unsigned char* lds = opq_l(lds_base()); PHASE_UNIFORMS();
    const int lane = opq_v(lane_id()), tid = wave * 64 + lane, g4 = lane >> 4, l15 = lane & 15;
    bf16* EV = (bf16*)(ws + WS_BIG);
    const float* LT = (const float*)(ws + WS_BIG + EV_LT_OFF);
    const float* gn = ap->in[I_EV_GNORM] + (size_t)j * 512;
    LAS float* ol = (LAS float*)lds;
    for (int u = vcu; u < BATCH * 4 * 64; u += G) {
        const int bh = u >> 6, c = u & 63, b = bh >> 2, h = bh & 3; const size_t m0 = (size_t)b * SEQ + c * 64;
        const int mb = wave >> 1;
        bf16x8 A[4];
#pragma unroll
        for (int ks = 0; ks < 4; ++ks) A[ks] = *(const bf16x8*)(EV + (m0 + 16 * mb + l15) * EVW + EC_GQ + h * 128 + 32 * ks + 8 * g4);
        const float* st = LT + (size_t)u * 128 * 128;
#pragma unroll
        for (int nn = 0; nn < 4; ++nn) { const int nb = 4 * (wave & 1) + nn; f32x4 acc = (f32x4){0.f, 0.f, 0.f, 0.f};
#pragma unroll
            for (int ks = 0; ks < 4; ++ks) { const float* sp = st + (size_t)(16 * nb + l15) * 128 + 32 * ks + 8 * g4; const f32x4 s0 = *(const f32x4*)sp, s1 = *(const f32x4*)(sp + 4);
                v4u t; t.x = pk2(s0[0], s0[1]); t.y = pk2(s0[2], s0[3]); t.z = pk2(s1[0], s1[1]); t.w = pk2(s1[2], s1[3]);
                acc = MFMA16(A[ks], __builtin_bit_cast(bf16x8, t), acc); }
#pragma unroll
            for (int i = 0; i < 4; ++i) { const int tt = 16 * mb + 4 * g4 + i, e = 16 * nb + l15; ol[tt * 132 + e] = acc[i] + bf2f(EV[(m0 + tt) * EVW + EC_GK + h * 128 + e]); } }
        __syncthreads();
        { const int t = tid >> 3, e0 = 16 * (tid & 7); float v[16], s = 0.f;
#pragma unroll
          for (int e = 0; e < 16; ++e) { v[e] = ol[t * 132 + e0 + e]; s += v[e]; }
          s += shx(s, 1, lane); s += shx(s, 2, lane); s += shx(s, 4, lane);
          const float mean = s * (1.f / 128.f); float s2 = 0.f;
#pragma unroll
          for (int e = 0; e < 16; ++e) { v[e] -= mean; s2 += v[e] * v[e]; }
          s2 += shx(s2, 1, lane); s2 += shx(s2, 2, lane); s2 += shx(s2, 4, lane);
          const float rstd = 1.f / sqrtf(s2 * (1.f / 128.f) + LN_EPS);
          bf16* gr = EV + (m0 + t) * EVW + EC_GR + h * 128 + e0;
#pragma unroll
          for (int hf = 0; hf < 2; ++hf) { const v4u rr = *(const v4u*)(gr + 8 * hf); const float rv[8] = {bflo(rr.x), bfhi(rr.x), bflo(rr.y), bfhi(rr.y), bflo(rr.z), bfhi(rr.z), bflo(rr.w), bfhi(rr.w)}; float y[8];
#pragma unroll
              for (int e = 0; e < 8; ++e) { const float gg = gn[h * 128 + e0 + 8 * hf + e]; y[e] = v[8 * hf + e] * rstd * gg * (rv[e] * sigmoidf_(rv[e])); }
              v4u o; o.x = pk2(y[0], y[1]); o.y = pk2(y[2], y[3]); o.z = pk2(y[4], y[5]); o.w = pk2(y[6], y[7]); *(v4u*)(gr + 8 * hf) = o; } }
        __syncthreads();
    }
}

__device__ __forceinline__ void even_mixer(const Frame& F, int j, const XcdBarrier& bar) {
    e2_index_topk(F);
    g1_gla_local(F, j);
    xcd_barrier(bar, F.wave);
    e3_attention(F);
    g2_gla_scan(F);
    xcd_barrier(bar, F.wave);
    g3_gla_out(F, j);
    xcd_barrier(bar, F.wave);
}
__global__ void __launch_bounds__(NWAVES * 64, 2) fwd(Args args) {
    Frame F;
    F.wave = __builtin_amdgcn_readfirstlane((int)threadIdx.x >> 6);
    F.G = gridDim.x; { const int bx = blockIdx.x; F.vcu = (F.G % 8 == 0) ? (bx % 8) * (F.G / 8) + bx / 8 : bx; }
    F.ap = (CArgs*)__builtin_amdgcn_kernarg_segment_ptr();
    { LAS unsigned* mz = (LAS unsigned*)(lds_base() + MISC_OFF); for (int u = threadIdx.x; u < (LDS_BYTES - MISC_OFF) / 4; u += NWAVES * 64) mz[u] = 0u; }
    __syncthreads();
    XcdBarrier bar = xcd_barrier_post((unsigned*)(F.ap->ws + WS_CTL) + CW_BAR, (volatile LAS unsigned*)(lds_base() + MISC_OFF) + 8, F.wave);
#define GRID_BAR() xcd_barrier(bar, F.wave)
#define WSP(off) ((bf16*)(opq_p(F.ap)->ws + (off)))

    x_to_bf16(F);
    convert_layer(F, 0);
    fold_small(F);
    GRID_BAR();

    for (int l = 0; l < DEPTH; ++l) {
        const int j = l >> 1;
        if ((l & 1) == 0) {
            { pg8::Gemm g{WSP(WS_XB), WSP(WS_WIN), M, EVW, DM, DM}; pg8::StaticOrder S; S.init(M, EVW, opq_s(F.G), opq_s((int)blockIdx.x));
              pg8::EpiBf16<0> E{WSP(WS_BIG), EVW};
              pg8::gemm_phase<pg8::EpiBf16<0>, pg8::StaticOrder, true, true>(opq_l(lds_base()), g, S, E, opq_s(F.wave)); }
            GRID_BAR();
            even_mixer(F, j, bar);
            { pg8::Gemm g{WSP(WS_BIG), WSP(WS_WOUT), M, DM, DM, EVW}; pg8::StaticOrder S; S.init(M, DM, opq_s(F.G), opq_s((int)blockIdx.x));
              pg8::EpiResid E{WSP(WS_XB), opq_p(F.ap)->out, ALPHA};
              pg8::gemm_phase<pg8::EpiResid, pg8::StaticOrder, true, true>(opq_l(lds_base()), g, S, E, opq_s(F.wave)); }
            GRID_BAR();
        } else {
            { pg8::Gemm g{WSP(WS_XB), WSP(WS_WIN), M, 4096, DM, DM}; pg8::StaticOrder S; S.init(M, 4096, opq_s(F.G), opq_s((int)blockIdx.x));
              pg8::EpiOddIn E{WSP(WS_BIG), (bf16*)opq_p(F.ap)->out};
              pg8::gemm_phase<pg8::EpiOddIn, pg8::StaticOrder, true, true>(opq_l(lds_base()), g, S, E, opq_s(F.wave)); }
            GRID_BAR();
            odd_mixer(F, j, bar);
            { pg8::Gemm g{WSP(WS_BIG), WSP(WS_WOUT), M, DM, MI, MI}; pg8::StaticOrder S; S.init(M, DM, opq_s(F.G), opq_s((int)blockIdx.x));
              pg8::EpiResid E{WSP(WS_XB), opq_p(F.ap)->out, ALPHA};
              pg8::gemm_phase<pg8::EpiResid, pg8::StaticOrder, true, true>(opq_l(lds_base()), g, S, E, opq_s(F.wave)); }
            GRID_BAR();
        }
        ln_phase(F, I_LN1G, I_LN1B, l, false);
        GRID_BAR();
        { pg8::Gemm g{WSP(WS_XB), WSP(WS_W1), M, FF, DM, DM}; pg8::StaticOrder S; S.init(M, FF, opq_s(F.G), opq_s((int)blockIdx.x));
          pg8::EpiBf16<1> E{WSP(WS_BIG), FF};
          pg8::gemm_phase<pg8::EpiBf16<1>, pg8::StaticOrder, true, true>(opq_l(lds_base()), g, S, E, opq_s(F.wave)); }
        GRID_BAR();
        { pg8::Gemm g{WSP(WS_BIG), WSP(WS_W2), M, DM, FF, FF}; pg8::StaticOrder S; S.init(M, DM, opq_s(F.G), opq_s((int)blockIdx.x));
          pg8::EpiResid E{WSP(WS_XB), opq_p(F.ap)->out, ALPHA};
          pg8::gemm_phase<pg8::EpiResid, pg8::StaticOrder, true, true>(opq_l(lds_base()), g, S, E, opq_s(F.wave)); }
        GRID_BAR();
        ln_phase(F, I_LN2G, I_LN2B, l, l == DEPTH - 1);
        if (l + 1 < DEPTH) { convert_layer(F, l + 1); GRID_BAR(); }
    }
}

extern "C" void kernel_launch(void* const* d_in, const int* in_sizes, int n_in, void* d_out, int out_size, void* d_ws, size_t ws_size, hipStream_t stream) {
    static int grid = 0;
    if (grid == 0) {
        if (n_in != 23 || in_sizes[0] != M * DM || out_size != M * DM || ws_size < WS_END) { fprintf(stderr, "kernel_launch: unexpected shapes / workspace (n_in %d, in0 %d, out %d, ws %zu); nothing launched\n", n_in, n_in > 0 ? in_sizes[0] : -1, out_size, ws_size); grid = -1; return; }
        int dev = 0, cus = 0, per_cu = 0;
        if (hipGetDevice(&dev) != hipSuccess || hipDeviceGetAttribute(&cus, hipDeviceAttributeMultiprocessorCount, dev) != hipSuccess) { grid = -1; return; }
        if (hipFuncSetAttribute((const void*)fwd, hipFuncAttributeMaxDynamicSharedMemorySize, LDS_BYTES) != hipSuccess) { fprintf(stderr, "kernel_launch: hipFuncSetAttribute failed\n"); grid = -1; return; }
        if (hipOccupancyMaxActiveBlocksPerMultiprocessor(&per_cu, (const void*)fwd, NWAVES * 64, LDS_BYTES) != hipSuccess || per_cu < 1) { fprintf(stderr, "kernel_launch: occupancy query reports %d\n", per_cu); }
        (void)hipGetLastError();
        grid = cus;
    }
    if (grid < 0) return;
    if (hipMemsetAsync((char*)d_ws + WS_CTL, 0, CTL_ZERO_BYTES, stream) != hipSuccess) return;
    Args a{};
    for (int i = 0; i < 23; ++i) a.in[i] = (const float*)d_in[i];
    a.out = (float*)d_out; a.ws = (unsigned char*)d_ws;
    hipLaunchKernelGGL(fwd, dim3(grid), dim3(NWAVES * 64), LDS_BYTES, stream, a);
}
```

```cpp
#include <hip/hip_runtime.h>
#include <cstdio>
#include <cstdint>
namespace pg8 {
#define PG8_LAS __attribute__((address_space(3)))
typedef unsigned short bf16_t;
typedef short bf16x8 __attribute__((ext_vector_type(8)));
typedef float f32x4 __attribute__((ext_vector_type(4)));
typedef unsigned u32x4 __attribute__((ext_vector_type(4)));
constexpr int BM = 256, BK = 64, HALF = 128, HTB = HALF * BK * 2  , STAGE_BYTES = 8 * HTB, NXCD = 8, WGM = 8;

__host__ __device__ __forceinline__ int lds_byte(int r, int c) { const int st = (r >> 4) * 2 + (c >> 5), rr = r & 15, cc = c & 31, ob = rr * 64 + cc * 2; return st * 1024 + (ob ^ (((ob >> 9) & 1) << 5)); }
__host__ __device__ __forceinline__ void stage_rc(int b, int& R, int& C) { const int st = b / 1024, sb = b % 1024, swz = sb ^ (((sb >> 9) & 1) << 5); R = (st >> 1) * 16 + swz / 64; C = (st & 1) * 32 + (swz % 64) / 2; }
__host__ __device__ __forceinline__ int perm32(int rho) { const int n = rho >> 4, i = rho & 15; return 8 * (i >> 2) + 4 * n + (i & 3); }

__device__ __forceinline__ int lane_id_v() { int x; asm volatile("v_mbcnt_lo_u32_b32 %0, -1, 0\n\tv_mbcnt_hi_u32_b32 %0, -1, %0" : "=v"(x)); return x; }
struct Unit { int pm, pn, idx; };
struct Gemm { const bf16_t* A; const bf16_t* Bt; int M, N, K, lda; };

struct StaticOrder {
    int nM, nN, nwg, G, c;
    __host__ __device__ void init(int M, int N, int G_, int c_) { nM = M / BM; nN = N / BM; nwg = nM * nN; G = G_; c = c_; }
    __host__ __device__ bool next(int i, Unit& u) const {
        const long L = (long)i * G + c; if (L >= nwg) return false;
        u.idx = i;
        int wgid = (int)L; { const int q = nwg / NXCD, r = nwg % NXCD, xcd = wgid % NXCD, off = wgid / NXCD; wgid = (xcd < r ? xcd * (q + 1) : r * (q + 1) + (xcd - r) * q) + off; }
        const int nig = WGM * nN, gid = wgid / nig, fm = gid * WGM, gsz = (nM - fm) < WGM ? (nM - fm) : WGM;
        u.pm = fm + ((wgid % nig) % gsz); u.pn = (wgid % nig) / gsz; return true;
    }
    __device__ __forceinline__ void a_ready(const Unit&) const {}
    __device__ __forceinline__ void done(const Unit&) const {}
};

typedef __bf16 pbf16x2_t __attribute__((ext_vector_type(2))); typedef float pf32x2_t __attribute__((ext_vector_type(2)));
__device__ __forceinline__ unsigned cvt_pk_bf16(float lo, float hi) { const pf32x2_t v = {lo, hi}; return __builtin_bit_cast(unsigned, __builtin_convertvector(v, pbf16x2_t)); }
__device__ __forceinline__ float bf_lo(unsigned w) { return __uint_as_float(w << 16); }
__device__ __forceinline__ float bf_hi(unsigned w) { return __uint_as_float(w & 0xffff0000u); }
__device__ __forceinline__ void st_wt16(const void* base, size_t off, u32x4 v) {
    __amdgpu_buffer_rsrc_t rs = __builtin_amdgcn_make_buffer_rsrc((void*)base, 0, 0x7FFFFFFF, 0x00020000);
    __builtin_amdgcn_raw_buffer_store_b128(v, rs, (int)(unsigned)off, 0, 16);
}

constexpr size_t LNW_XB = (size_t)41 << 20, LNW_PS0 = (size_t)505 << 20, LNW_PS1 = ((size_t)29 << 20) + ((size_t)11 << 20), LNW_COLV = ((size_t)29 << 20) + ((size_t)8 << 20) + ((size_t)512 << 10), LNW_LNV = LNW_COLV + 65536;
constexpr int LN_ST_OFF = 131072, LN_RED_OFF = 147456, LN_COL_OFF = 155648;
__device__ __forceinline__ PG8_LAS float* ln_lds(int off) { extern __shared__ __attribute__((aligned(16))) unsigned char lds_raw[]; return (PG8_LAS float*)((PG8_LAS unsigned char*)lds_raw + off); }
__device__ __forceinline__ const f32x4* ln_ps(unsigned char* ws, int psel) { return (const f32x4*)(ws + (psel ? LNW_PS1 : LNW_PS0)); }
struct LNFold { unsigned char* ws; int psel, csel, on; };
__device__ __forceinline__ void ln_stage_cols(const float* v0, const float* v1, int pn, int idx, int wid, int lane) {
    if (wid < 2) { const float* src = (wid ? v1 : v0) + pn * BM + lane * 4;
        __builtin_amdgcn_global_load_lds((const unsigned*)src, (PG8_LAS unsigned*)(ln_lds(LN_COL_OFF) + ((idx & 1) * 2 + wid) * 256), 16, 0, 0); }
}
struct LNPrep { f32x4 p[8]; };
template <class Sched>
__device__ __forceinline__ void ln_prepare_issue(const f32x4* PS, int on, const Sched& S, int tid, LNPrep& P) {
    if (!on) return;
#pragma unroll
    for (int i = 0; i < 8; ++i) { Unit u; const bool ok = S.next(i, u); const int r = (ok ? u.pm : 0) * BM + (tid >> 1); P.p[i] = PS[(size_t)r * 2 + (tid & 1)]; }
}
__device__ __forceinline__ void ln_prepare_finish(int on, PG8_LAS float* st, int tid, const LNPrep& P) {
    if (!on) return;
#pragma unroll
    for (int i = 0; i < 8; ++i) { float S_ = P.p[i][0] + P.p[i][2], Q_ = P.p[i][1] + P.p[i][3];
        S_ += __builtin_bit_cast(float, __builtin_amdgcn_ds_bpermute(((tid & 63) ^ 1) << 2, __builtin_bit_cast(int, S_)));
        Q_ += __builtin_bit_cast(float, __builtin_amdgcn_ds_bpermute(((tid & 63) ^ 1) << 2, __builtin_bit_cast(int, Q_)));
        const float mu = S_ * (1.0f / 1024.0f), var = fmaxf(Q_ * (1.0f / 1024.0f) - mu * mu, 0.f), rs = __builtin_amdgcn_rsqf(var + 1e-5f);
        if ((tid & 1) == 0) { st[(i * BM + (tid >> 1)) * 2] = rs; st[(i * BM + (tid >> 1)) * 2 + 1] = -mu * rs; } }
}
typedef float pf32x2s_t __attribute__((ext_vector_type(2)));
__device__ __forceinline__ void ln_row(const PG8_LAS float* st, int on, int idx, int rl, float& rs, float& nmrs) {
    const pf32x2s_t v = *(const PG8_LAS pf32x2s_t*)(st + (idx * BM + rl) * 2);
    rs = on ? v[0] : 1.f; nmrs = on ? v[1] : 0.f;
}
struct LNCols { f32x4 c[2][2], b[2][2]; };
__device__ __forceinline__ void ln_cols(int on, int idx, int cl, LNCols& C) {
    const PG8_LAS float* cb = ln_lds(LN_COL_OFF) + (idx & 1) * 512 + cl; const f32x4 z = {0.f, 0.f, 0.f, 0.f};
#pragma unroll
    for (int bj = 0; bj < 2; ++bj)
#pragma unroll
        for (int h = 0; h < 2; ++h) { const f32x4 c = *(const PG8_LAS f32x4*)(cb + bj * HALF + 4 * h), b = *(const PG8_LAS f32x4*)(cb + 256 + bj * HALF + 4 * h);
            C.c[bj][h] = on ? c : z; C.b[bj][h] = on ? b : z; }
}
__device__ __forceinline__ void ln_fix(f32x4& v0, f32x4& v1, float rs, float nmrs, const LNCols& C, int bj) {
    const pf32x2_t rs2 = {rs, rs}, nm2 = {nmrs, nmrs};
#pragma unroll
    for (int j = 0; j < 4; j += 2) {
        const pf32x2_t a = {v0[j], v0[j + 1]}, c = {C.c[bj][0][j], C.c[bj][0][j + 1]}, b = {C.b[bj][0][j], C.b[bj][0][j + 1]}; const pf32x2_t r = __builtin_elementwise_fma(rs2, a, __builtin_elementwise_fma(nm2, c, b)); v0[j] = r[0]; v0[j + 1] = r[1];
        const pf32x2_t a1 = {v1[j], v1[j + 1]}, c1 = {C.c[bj][1][j], C.c[bj][1][j + 1]}, b1 = {C.b[bj][1][j], C.b[bj][1][j + 1]}; const pf32x2_t r1 = __builtin_elementwise_fma(rs2, a1, __builtin_elementwise_fma(nm2, c1, b1)); v1[j] = r1[0]; v1[j + 1] = r1[1]; }
}

template <int ACT> struct EpiBf16 {
    static constexpr bool PERM = true, AFTER_DRAIN = false;
    bf16_t* O; int ldc; LNFold L;
    template <class Sched> __device__ __forceinline__ void prepare_issue(const Sched& S, int tid, LNPrep& P) const { ln_prepare_issue(ln_ps(L.ws, L.psel), L.on, S, tid, P); }
    __device__ __forceinline__ void prepare_finish(int tid, const LNPrep& P) const { ln_prepare_finish(L.on, ln_lds(LN_ST_OFF), tid, P); }
    __device__ __forceinline__ void stage(const Unit& u, int wid, int lane) const { if (L.on) { const float* cs = (const float*)(L.ws + LNW_COLV) + L.csel * 8192; ln_stage_cols(cs, cs + 4096, u.pn, u.idx, wid, lane); } }
    __device__ __forceinline__ void operator()(const f32x4 (&acc)[2][2][4][2], const Unit& u, int wr, int wc, int fr_, int fq_) const {
        const int fr = fr_, fq = fq_;
        const int row0 = u.pm * BM + wr * 64 + fr, col0 = u.pn * BM + wc * 32 + 8 * fq;
        LNCols C; ln_cols(L.on, u.idx, wc * 32 + 8 * fq, C);
#pragma unroll
        for (int ai = 0; ai < 2; ++ai) {
#pragma unroll
            for (int m = 0; m < 4; ++m) { const int r = row0 + ai * HALF + m * 16; bf16_t* rowp = O + (size_t)r * ldc + col0;
                float rs, nmrs; ln_row(ln_lds(LN_ST_OFF), L.on, u.idx, ai * HALF + wr * 64 + m * 16 + fr, rs, nmrs);
#pragma unroll
                for (int bj = 0; bj < 2; ++bj) { f32x4 v0 = acc[ai][bj][m][0], v1 = acc[ai][bj][m][1];
                    ln_fix(v0, v1, rs, nmrs, C, bj);
                    if (ACT == 1) {
#pragma unroll
                        for (int j = 0; j < 4; ++j) { const float a = fmaxf(v0[j], 0.f), b = fmaxf(v1[j], 0.f); v0[j] = a * a; v1[j] = b * b; } }
                    u32x4 w; w.x = cvt_pk_bf16(v0[0], v0[1]); w.y = cvt_pk_bf16(v0[2], v0[3]); w.z = cvt_pk_bf16(v1[0], v1[1]); w.w = cvt_pk_bf16(v1[2], v1[3]);
                    st_wt16(O, ((size_t)r * ldc + col0 + bj * HALF) * 2, w); } } }
    }
};
struct EpiEvenIn {
    static constexpr bool PERM = true, AFTER_DRAIN = false;
    bf16_t* O; int ldc; bf16_t* IKt; int ik0; LNFold L;
    template <class Sched> __device__ __forceinline__ void prepare_issue(const Sched& S, int tid, LNPrep& P) const { ln_prepare_issue(ln_ps(L.ws, L.psel), L.on, S, tid, P); }
    __device__ __forceinline__ void prepare_finish(int tid, const LNPrep& P) const { ln_prepare_finish(L.on, ln_lds(LN_ST_OFF), tid, P); }
    __device__ __forceinline__ void stage(const Unit& u, int wid, int lane) const { if (L.on) { const float* cs = (const float*)(L.ws + LNW_COLV) + L.csel * 8192; ln_stage_cols(cs, cs + 4096, u.pn, u.idx, wid, lane); } }
    __device__ __forceinline__ void operator()(const f32x4 (&acc)[2][2][4][2], const Unit& u, int wr, int wc, int fr_, int fq_) const {
        const int fr = fr_, fq = fq_;
        const int row0 = u.pm * BM + wr * 64 + fr, col0 = u.pn * BM + wc * 32 + 8 * fq;
        LNCols C; ln_cols(L.on, u.idx, wc * 32 + 8 * fq, C);
#pragma unroll
        for (int ai = 0; ai < 2; ++ai) {
#pragma unroll
            for (int m = 0; m < 4; ++m) { const int r = row0 + ai * HALF + m * 16; bf16_t* rowp = O + (size_t)r * ldc + col0;
                float rs, nmrs; ln_row(ln_lds(LN_ST_OFF), L.on, u.idx, ai * HALF + wr * 64 + m * 16 + fr, rs, nmrs);
#pragma unroll
                for (int bj = 0; bj < 2; ++bj) { f32x4 v0 = acc[ai][bj][m][0], v1 = acc[ai][bj][m][1];
                    ln_fix(v0, v1, rs, nmrs, C, bj);
                    u32x4 w; w.x = cvt_pk_bf16(v0[0], v0[1]); w.y = cvt_pk_bf16(v0[2], v0[3]); w.z = cvt_pk_bf16(v1[0], v1[1]); w.w = cvt_pk_bf16(v1[2], v1[3]);
                    st_wt16(O, ((size_t)r * ldc + col0 + bj * HALF) * 2, w);
                    const int d0 = col0 + bj * HALF - ik0;
                    if (d0 >= 0 && d0 < 64) st_wt16(IKt, ((size_t)((r >> 5) * 4 + (d0 >> 4)) * 64 + ((d0 >> 3) & 1) * 32 + (r & 31)) * 16, w); } } }
    }
};
struct EpiOddIn {
    static constexpr bool PERM = true, AFTER_DRAIN = false;
    bf16_t* XM; bf16_t* OG; LNFold L;
    template <class Sched> __device__ __forceinline__ void prepare_issue(const Sched& S, int tid, LNPrep& P) const { ln_prepare_issue(ln_ps(L.ws, L.psel), L.on, S, tid, P); }
    __device__ __forceinline__ void prepare_finish(int tid, const LNPrep& P) const { ln_prepare_finish(L.on, ln_lds(LN_ST_OFF), tid, P); }
    __device__ __forceinline__ void stage(const Unit& u, int wid, int lane) const { if (L.on) { const float* cs = (const float*)(L.ws + LNW_COLV) + L.csel * 8192; ln_stage_cols(cs, cs + 4096, u.pn, u.idx, wid, lane); } }
    __device__ __forceinline__ void operator()(const f32x4 (&acc)[2][2][4][2], const Unit& u, int wr, int wc, int fr_, int fq_) const {
        const int fr = fr_, fq = fq_;
        const bool gate = u.pn >= 8;
        bf16_t* base = gate ? OG : XM;
        const int row0 = u.pm * BM + wr * 64 + fr, col0 = (u.pn & 7) * BM + wc * 32 + 8 * fq;
        LNCols C; ln_cols(L.on, u.idx, wc * 32 + 8 * fq, C);
#pragma unroll
        for (int ai = 0; ai < 2; ++ai) {
#pragma unroll
            for (int m = 0; m < 4; ++m) { const int r = row0 + ai * HALF + m * 16; bf16_t* rowp = base + (size_t)r * 2048 + col0;
                float rs, nmrs; ln_row(ln_lds(LN_ST_OFF), L.on, u.idx, ai * HALF + wr * 64 + m * 16 + fr, rs, nmrs);
#pragma unroll
                for (int bj = 0; bj < 2; ++bj) { f32x4 v0 = acc[ai][bj][m][0], v1 = acc[ai][bj][m][1];
                    ln_fix(v0, v1, rs, nmrs, C, bj);
                    if (gate) {
#pragma unroll
                        for (int j = 0; j < 4; ++j) { v0[j] = __builtin_amdgcn_rcpf(1.0f + __expf(-v0[j])); v1[j] = __builtin_amdgcn_rcpf(1.0f + __expf(-v1[j])); } }
                    u32x4 w; w.x = cvt_pk_bf16(v0[0], v0[1]); w.y = cvt_pk_bf16(v0[2], v0[3]); w.z = cvt_pk_bf16(v1[0], v1[1]); w.w = cvt_pk_bf16(v1[2], v1[3]);
                    st_wt16(base, ((size_t)r * 2048 + col0 + bj * HALF) * 2, w); } } }
    }
};
struct EpiResidLN {
    static constexpr bool PERM = true, AFTER_DRAIN = false;
    unsigned char* ws; int psel, gsel, on; float alpha;
    template <class Sched> __device__ __forceinline__ void prepare_issue(const Sched& S, int tid, LNPrep& P) const { ln_prepare_issue(ln_ps(ws, psel), on, S, tid, P); }
    __device__ __forceinline__ void prepare_finish(int tid, const LNPrep& P) const { ln_prepare_finish(on, ln_lds(LN_ST_OFF), tid, P); }
    __device__ __forceinline__ void stage(const Unit& u, int wid, int lane) const { if (on) { const float* g = (const float*)(ws + LNW_LNV) + gsel * 1024; ln_stage_cols(g, g + 4 * 1024, u.pn, u.idx, wid, lane); } }
    __device__ __forceinline__ void operator()(const f32x4 (&acc)[2][2][4][2], const Unit& u, int wr, int wc, int fr_, int fq_) const {
        const int fr = fr_, fq = fq_;
        const int row0 = u.pm * BM + wr * 64 + fr, col0 = u.pn * BM + wc * 32 + 8 * fq, lane = fq * 16 + fr;
        bf16_t* T = (bf16_t*)(ws + LNW_XB); float* PSout = (float*)(ws + (psel ? LNW_PS0 : LNW_PS1));
        PG8_LAS float* st = ln_lds(LN_ST_OFF); PG8_LAS float* red = ln_lds(LN_RED_OFF);
        f32x4 ag[2][2], ab[2][2];
#pragma unroll
        for (int bj = 0; bj < 2; ++bj)
#pragma unroll
            for (int h = 0; h < 2; ++h) {
                const PG8_LAS float* cb = ln_lds(LN_COL_OFF) + (u.idx & 1) * 512 + wc * 32 + 8 * fq + bj * HALF + 4 * h; const f32x4 gq = *(const PG8_LAS f32x4*)cb, bq = *(const PG8_LAS f32x4*)(cb + 256);
                ag[bj][h] = on ? gq * alpha : (f32x4){alpha, alpha, alpha, alpha}; ab[bj][h] = on ? bq * alpha : (f32x4){0.f, 0.f, 0.f, 0.f}; }
#pragma unroll
        for (int ai = 0; ai < 2; ++ai) {
            float sq[4][2];
            u32x4 xb[4][2];
#pragma unroll
            for (int m = 0; m < 4; ++m)
#pragma unroll
                for (int bj = 0; bj < 2; ++bj) xb[m][bj] = *(const u32x4*)(T + (size_t)(row0 + ai * HALF + m * 16) * 1024 + col0 + bj * HALF);
            asm volatile("" ::: "memory");
#pragma unroll
            for (int m = 0; m < 4; ++m) { const int r = row0 + ai * HALF + m * 16; const size_t off = (size_t)r * 1024 + col0;
                float rs, nmrs; ln_row(st, on, u.idx, ai * HALF + wr * 64 + m * 16 + fr, rs, nmrs);
                const pf32x2_t rs2 = {rs, rs}, nm2 = {nmrs, nmrs}; pf32x2_t s2 = {0.f, 0.f}, q2 = {0.f, 0.f};
#pragma unroll
                for (int bj = 0; bj < 2; ++bj) { const size_t o2 = off + bj * HALF; const u32x4 x = xb[m][bj];
                    const unsigned xw[4] = {x.x, x.y, x.z, x.w}; unsigned ww[4];
#pragma unroll
                    for (int p = 0; p < 4; ++p) { const int h = p >> 1, j = (p & 1) * 2;
                        const pf32x2_t t = {bf_lo(xw[p]), bf_hi(xw[p])}, g2 = {ag[bj][h][j], ag[bj][h][j + 1]}, b2 = {ab[bj][h][j], ab[bj][h][j + 1]}, a2 = {acc[ai][bj][m][h][j], acc[ai][bj][m][h][j + 1]};
                        const pf32x2_t v = __builtin_elementwise_fma(t, rs2 * g2, __builtin_elementwise_fma(nm2, g2, b2)) + a2;
                        ww[p] = cvt_pk_bf16(v[0], v[1]);
                        const pf32x2_t e = {bf_lo(ww[p]), bf_hi(ww[p])};
                        s2 += e; q2 = __builtin_elementwise_fma(e, e, q2); }
                    u32x4 w; w.x = ww[0]; w.y = ww[1]; w.z = ww[2]; w.w = ww[3];
                    st_wt16(T, o2 * 2, w); }
                sq[m][0] = s2[0] + s2[1]; sq[m][1] = q2[0] + q2[1]; }
#pragma unroll
            for (int m = 0; m < 4; ++m)
#pragma unroll
                for (int k = 0; k < 2; ++k) sq[m][k] += __builtin_bit_cast(float, __builtin_amdgcn_ds_bpermute((lane ^ 16) << 2, __builtin_bit_cast(int, sq[m][k])));
#pragma unroll
            for (int m = 0; m < 4; ++m)
#pragma unroll
                for (int k = 0; k < 2; ++k) sq[m][k] += __builtin_bit_cast(float, __builtin_amdgcn_ds_bpermute((lane ^ 32) << 2, __builtin_bit_cast(int, sq[m][k])));
            if (fq == 0) {
#pragma unroll
                for (int m = 0; m < 4; ++m) { const int rl = ai * HALF + wr * 64 + m * 16 + fr; red[(rl * 4 + wc) * 2] = sq[m][0]; red[(rl * 4 + wc) * 2 + 1] = sq[m][1]; } } }
        asm volatile("s_waitcnt lgkmcnt(0)" ::: "memory"); __builtin_amdgcn_s_barrier();
        { const int tid = (wr * 4 + wc) * 64 + lane;
          if (tid < BM) { const f32x4 p01 = *(const PG8_LAS f32x4*)(red + tid * 8), p23 = *(const PG8_LAS f32x4*)(red + tid * 8 + 4);
              float* o = PSout + ((size_t)(u.pm * BM + tid) * 4 + u.pn) * 2;
              __hip_atomic_store(o, (p01[0] + p01[2]) + (p23[0] + p23[2]), __ATOMIC_RELAXED, __HIP_MEMORY_SCOPE_AGENT); __hip_atomic_store(o + 1, (p01[1] + p01[3]) + (p23[1] + p23[3]), __ATOMIC_RELAXED, __HIP_MEMORY_SCOPE_AGENT); } }
    }
};

template <class Epi, class Sched, bool ALIGN_EPI = false, bool SP2 = false>
__device__ __forceinline__ void gemm_phase(PG8_LAS unsigned char* lds, const Gemm g, const Sched& S, const Epi& E, int wid_in) {
    const int wid = wid_in, lane = lane_id_v(), tid = wid * 64 + lane, wr = wid >> 2, wc = wid & 3, fr = lane & 15, fq = lane >> 4;
    const int K = g.K, nt = K / BK;
    unsigned voffA[2], voffB[2];
#pragma unroll
    for (int i = 0; i < 2; ++i) { int R, C; stage_rc(tid * 16 + i * 8192, R, C); const int Rb = Epi::PERM ? ((R & ~31) + perm32(R & 31)) : R;
        voffA[i] = (unsigned)(R * g.lda + C) * 2u; voffB[i] = (unsigned)(Rb * K + C) * 2u; }
    const size_t kstep = (size_t)(BK * 2);
    const size_t hstep = (size_t)HALF * K * 2;
    const size_t tstep = 2 * hstep;
    const size_t hstepA = (size_t)HALF * g.lda * 2, tstepA = 2 * hstepA;
    const unsigned ldsw = (unsigned)wid * 1024u;
    const int aoff = lds_byte(wr * 64 + fr, fq * 8), boff = lds_byte(wc * 32 + fr, fq * 8);
#define PG8_SA(b, h) (((b) * 2 + (h)) * HTB)
#define PG8_SB(b, h) ((4 + (b) * 2 + (h)) * HTB)
#define PG8_STAGE(bufoff, gbase, voff) do { _Pragma("unroll") for (int _i = 0; _i < 2; ++_i) \
        __builtin_amdgcn_global_load_lds((const unsigned*)((const char*)(gbase) + (voff)[_i]), (PG8_LAS unsigned*)(lds + (bufoff) + ldsw + _i * 8192), 16, 0, 0); } while (0)
#define PG8_LDA(dst, b, h) do { _Pragma("unroll") for (int m = 0; m < 4; ++m) _Pragma("unroll") for (int k = 0; k < 2; ++k) dst[m][k] = *(const PG8_LAS bf16x8*)(lds + PG8_SA(b, h) + aoff + m * 2048 + k * 1024); } while (0)
#define PG8_LDB(dst, b, h) do { _Pragma("unroll") for (int n = 0; n < 2; ++n) _Pragma("unroll") for (int k = 0; k < 2; ++k) dst[n][k] = *(const PG8_LAS bf16x8*)(lds + PG8_SB(b, h) + boff + n * 2048 + k * 1024); } while (0)
#define PG8_MMA(ai, bj, At, Bt) do { __builtin_amdgcn_s_setprio(1); _Pragma("unroll") for (int m = 0; m < 4; ++m) _Pragma("unroll") for (int n = 0; n < 2; ++n) _Pragma("unroll") for (int k = 0; k < 2; ++k) \
        acc[ai][bj][m][n] = __builtin_amdgcn_mfma_f32_16x16x32_bf16(Bt[n][k], At[m][k], acc[ai][bj][m][n], 0, 0, 0); __builtin_amdgcn_s_setprio(0); } while (0)
#define PG8_WAIT_V(n) asm volatile("s_waitcnt vmcnt(" #n ")" ::: "memory")
#define PG8_WAIT_L(n) asm volatile("s_waitcnt lgkmcnt(" #n ")" ::: "memory")
#define PG8_BAR __builtin_amdgcn_s_barrier()
#define PG8_SCHED __builtin_amdgcn_sched_barrier(0)
    Unit cur, nxt; int ui = 0;
    LNPrep lnprep; E.prepare_issue(S, tid, lnprep);
    if (!S.next(0, cur)) return;
    f32x4 acc[2][2][4][2];
#pragma unroll
    for (int a = 0; a < 2; ++a)
#pragma unroll
        for (int b = 0; b < 2; ++b)
#pragma unroll
            for (int m = 0; m < 4; ++m)
#pragma unroll
                for (int n = 0; n < 2; ++n) acc[a][b][m][n] = (f32x4){0.f, 0.f, 0.f, 0.f};
    bf16x8 At[4][2], B0[2][2], B1[2][2];
    const char* cA = (const char*)g.A + (size_t)cur.pm * tstepA; const char* cB = (const char*)g.Bt + (size_t)cur.pn * tstep;
    S.a_ready(cur);
    E.stage(cur, wid, lane_id_v());
    if constexpr (SP2) {
        PG8_STAGE(PG8_SB(0, 0), cB, voffB); PG8_STAGE(PG8_SB(0, 1), cB + hstep, voffB); PG8_STAGE(PG8_SA(0, 0), cA, voffA); PG8_STAGE(PG8_SA(0, 1), cA + hstepA, voffA);
        if (wr == 1) PG8_BAR;
        PG8_WAIT_V(2); PG8_BAR;
        PG8_STAGE(PG8_SB(1, 0), cB + kstep, voffB); PG8_STAGE(PG8_SA(1, 0), cA + kstep, voffA); PG8_STAGE(PG8_SB(1, 1), cB + hstep + kstep, voffB);
        PG8_WAIT_V(6); PG8_BAR;
    } else {
        PG8_STAGE(PG8_SB(0, 0), cB, voffB); PG8_STAGE(PG8_SA(0, 0), cA, voffA); PG8_STAGE(PG8_SB(0, 1), cB + hstep, voffB); PG8_STAGE(PG8_SA(0, 1), cA + hstepA, voffA);
        if (wr == 1) PG8_BAR;
        PG8_WAIT_V(4); PG8_BAR;
        PG8_STAGE(PG8_SB(1, 0), cB + kstep, voffB); PG8_STAGE(PG8_SA(1, 0), cA + kstep, voffA); PG8_STAGE(PG8_SB(1, 1), cB + hstep + kstep, voffB);
        PG8_WAIT_V(6); PG8_BAR;
    }
    E.prepare_finish(tid, lnprep);
    for (;;) {
        const bool has_next = S.next(ui + 1, nxt);
        const char* nA = has_next ? (const char*)g.A + (size_t)nxt.pm * tstepA : cA; const char* nB = has_next ? (const char*)g.Bt + (size_t)nxt.pn * tstep : cB;
        for (int t = 0; t < nt; t += 2) {
            const bool last = (t == nt - 2);
            const char* a1 = cA + (size_t)(t + 1) * kstep;
            const char* a2 = last ? nA : cA + (size_t)(t + 2) * kstep; const char* b2 = last ? nB : cB + (size_t)(t + 2) * kstep;
            const char* a3 = a2 + kstep; const char* b3 = b2 + kstep;
            if (last && has_next) S.a_ready(nxt);
            if constexpr (SP2) {
            PG8_LDB(B0, 0, 0); PG8_LDB(B1, 0, 1); PG8_SCHED; PG8_LDA(At, 0, 0); PG8_STAGE(PG8_SA(1, 1), a1 + hstepA, voffA);
            PG8_WAIT_V(8); PG8_WAIT_L(0); PG8_BAR; PG8_MMA(0, 0, At, B0); PG8_MMA(0, 1, At, B1); PG8_BAR; PG8_SCHED;
            PG8_LDA(At, 0, 1); PG8_STAGE(PG8_SB(0, 0), b2, voffB); PG8_STAGE(PG8_SB(0, 1), b2 + hstep, voffB); PG8_STAGE(PG8_SA(0, 0), a2, voffA);
            PG8_WAIT_V(8); PG8_WAIT_L(0); PG8_BAR; PG8_MMA(1, 0, At, B0); PG8_MMA(1, 1, At, B1); PG8_BAR; PG8_SCHED;
            PG8_LDB(B0, 1, 0); PG8_LDB(B1, 1, 1); PG8_SCHED; PG8_LDA(At, 1, 0); PG8_STAGE(PG8_SA(0, 1), a2 + hstepA, voffA);
            PG8_WAIT_V(8); PG8_WAIT_L(0); PG8_BAR; PG8_MMA(0, 0, At, B0); PG8_MMA(0, 1, At, B1); PG8_BAR; PG8_SCHED;
            PG8_LDA(At, 1, 1); PG8_STAGE(PG8_SB(1, 0), b3, voffB); PG8_STAGE(PG8_SB(1, 1), b3 + hstep, voffB); PG8_STAGE(PG8_SA(1, 0), a3, voffA);
            PG8_WAIT_V(8); PG8_WAIT_L(0); PG8_BAR; PG8_MMA(1, 0, At, B0); PG8_MMA(1, 1, At, B1); PG8_BAR; PG8_SCHED;
            } else {
            PG8_LDB(B0, 0, 0); PG8_SCHED; PG8_LDA(At, 0, 0); PG8_STAGE(PG8_SA(1, 1), a1 + hstepA, voffA);
            PG8_WAIT_L(8); PG8_BAR; PG8_WAIT_L(0); PG8_MMA(0, 0, At, B0); PG8_BAR; PG8_SCHED;
            PG8_LDB(B1, 0, 1); PG8_STAGE(PG8_SB(0, 0), b2, voffB);
            PG8_BAR; PG8_WAIT_L(0); PG8_MMA(0, 1, At, B1); PG8_BAR;
            PG8_LDA(At, 0, 1); PG8_STAGE(PG8_SA(0, 0), a2, voffA);
            PG8_BAR; PG8_WAIT_L(0); PG8_MMA(1, 0, At, B0); PG8_BAR; PG8_SCHED;
            PG8_STAGE(PG8_SB(0, 1), b2 + hstep, voffB);
            PG8_WAIT_V(6); PG8_BAR; PG8_MMA(1, 1, At, B1); PG8_BAR;
            PG8_LDB(B0, 1, 0); PG8_SCHED; PG8_LDA(At, 1, 0); PG8_STAGE(PG8_SA(0, 1), a2 + hstepA, voffA);
            PG8_WAIT_L(8); PG8_BAR; PG8_WAIT_L(0); PG8_MMA(0, 0, At, B0); PG8_BAR; PG8_SCHED;
            PG8_LDB(B1, 1, 1); PG8_STAGE(PG8_SB(1, 0), b3, voffB);
            PG8_BAR; PG8_WAIT_L(0); PG8_MMA(0, 1, At, B1); PG8_BAR;
            PG8_LDA(At, 1, 1); PG8_STAGE(PG8_SA(1, 0), a3, voffA);
            PG8_BAR; PG8_WAIT_L(0); PG8_MMA(1, 0, At, B0); PG8_BAR; PG8_SCHED;
            PG8_STAGE(PG8_SB(1, 1), b3 + hstep, voffB);
            PG8_WAIT_V(6); PG8_BAR; PG8_MMA(1, 1, At, B1); PG8_BAR;
            }
        }
        if (has_next) E.stage(nxt, wid, lane_id_v());
        if constexpr (ALIGN_EPI) { if (wr == 0) PG8_BAR; }
        if constexpr (!Epi::AFTER_DRAIN) { const int l2 = lane_id_v(); E(acc, cur, wr, wc, l2 & 15, l2 >> 4); S.done(cur); }
        if (!has_next) break;
#pragma unroll
        for (int a = 0; a < 2; ++a)
#pragma unroll
            for (int b = 0; b < 2; ++b)
#pragma unroll
                for (int m = 0; m < 4; ++m)
#pragma unroll
                    for (int n = 0; n < 2; ++n) acc[a][b][m][n] = (f32x4){0.f, 0.f, 0.f, 0.f};
        cur = nxt; cA = nA; cB = nB; ++ui;
        if constexpr (ALIGN_EPI) { if (wr == 1) PG8_BAR; }
    }
    PG8_WAIT_V(0);
    if constexpr (!ALIGN_EPI) { if (wr == 0) PG8_BAR; }
    PG8_BAR;
    if constexpr (Epi::AFTER_DRAIN) { E.fused(acc, cur, wr, wc, fr, fq, lds, wid, lane); S.done(cur); }
#undef PG8_SA
#undef PG8_SB
#undef PG8_STAGE
#undef PG8_LDA
#undef PG8_LDB
#undef PG8_MMA
#undef PG8_WAIT_V
#undef PG8_WAIT_L
#undef PG8_BAR
#undef PG8_SCHED
}
}
constexpr int BATCH = 8, SEQ = 4096, DM = 1024, DEPTH = 4, FF = 4096;
constexpr int M = BATCH * SEQ;
constexpr float ALPHA = 1.6817928305074290f;
constexpr float LN_EPS = 1e-5f;
constexpr int NWAVES = 8;
constexpr int EVW = 3328;
constexpr int EC_AQ = 0, EC_GR = 512, EC_GQ = 1024, EC_GK = 1536, EC_GV = 2048, EC_IQ = 2560, EC_AK = 3072, EC_AV = 3136, EC_IK = 3200, EC_IW = 3264, EC_GLR = 3296;
constexpr int EV_SRCW = 3288;
constexpr size_t EV_IKT_OFF = (size_t)280 << 20;
constexpr int MI = 2048, MH = 4, MDH = 512, MCH = 64, NCH = SEQ / MCH;

constexpr size_t MiB = 1u << 20;
constexpr size_t WS_CTL = 0, CTL_ZERO_BYTES = 1 * MiB;
constexpr size_t WS_WIN = 1 * MiB, WS_WOUT = 9 * MiB, WS_W1 = 13 * MiB, WS_W2 = 21 * MiB;
constexpr size_t WS_SMALL = 29 * MiB;
constexpr size_t WS_XB = 41 * MiB;
constexpr size_t WS_AUX = 105 * MiB;
constexpr size_t WS_BIG = 121 * MiB;
constexpr size_t WS_PS0 = 505 * MiB;
constexpr size_t WS_END = 506 * MiB;
constexpr size_t SM_GATEW = 0;
constexpr size_t SM_KFOLD = 512 * 1024;
constexpr size_t SM_LI = 1 * MiB;
constexpr size_t SM_BC = 2 * MiB;
constexpr size_t SM_CHG = 3 * MiB;
constexpr size_t SM_WIN = 4 * MiB;
constexpr size_t SM_DEN = 5 * MiB;
constexpr size_t SM_EMM = 6 * MiB;
constexpr size_t SM_WK = 7 * MiB;
constexpr size_t SM_DEC = 8 * MiB;
constexpr size_t SM_GWT = 10 * MiB;
constexpr size_t SM_COLV = 8 * MiB + 512 * 1024;
constexpr size_t SM_PS1 = 11 * MiB;
constexpr int CW_BAR = 4096;

constexpr int RING_BYTES = 131072;
constexpr int LDSX_OFF = RING_BYTES;
constexpr int LDS_ST_OFF = RING_BYTES, LDS_RED_OFF = LDS_ST_OFF + 16384;
constexpr int LDS_COL_OFF = LDS_RED_OFF + 8192;
constexpr int MISC_OFF = 159744;
constexpr int LDS_BYTES = 161792;

#define GAS __attribute__((address_space(1)))
#define LAS __attribute__((address_space(3)))
typedef unsigned short bf16;
typedef unsigned v4u __attribute__((ext_vector_type(4)));
typedef unsigned v2u __attribute__((ext_vector_type(2)));
typedef float f32x4 __attribute__((ext_vector_type(4)));
typedef float f32x16 __attribute__((ext_vector_type(16)));
typedef short bf16x8 __attribute__((ext_vector_type(8)));
typedef short s16x4 __attribute__((ext_vector_type(4)));
typedef GAS unsigned gu32;
#define RLX_AGENT __ATOMIC_RELAXED, __HIP_MEMORY_SCOPE_AGENT
#define LDS_WAIT() asm volatile("s_waitcnt lgkmcnt(0)" ::: "memory")
#define VM_WAIT() asm volatile("s_waitcnt vmcnt(0)" ::: "memory")
typedef __bf16 bf16x2_t __attribute__((ext_vector_type(2)));
typedef float f32x2_t __attribute__((ext_vector_type(2)));
__device__ __forceinline__ unsigned pk2(float lo, float hi) { const f32x2_t v = {lo, hi}; return __builtin_bit_cast(unsigned, __builtin_convertvector(v, bf16x2_t)); }
__device__ __forceinline__ unsigned f2bf(float f) { return pk2(f, f) & 0xffffu; }
__device__ __forceinline__ float bf2f(unsigned short b) { return __uint_as_float(((unsigned)b) << 16); }
__device__ __forceinline__ float bflo(unsigned w) { return __uint_as_float(w << 16); }
__device__ __forceinline__ float bfhi(unsigned w) { return __uint_as_float(w & 0xffff0000u); }
__device__ __forceinline__ float shx(float v, int o, int lane) { return __builtin_bit_cast(float, __builtin_amdgcn_ds_bpermute((lane ^ o) << 2, __builtin_bit_cast(int, v))); }
__device__ __forceinline__ float shi(float v, int src) { return __builtin_bit_cast(float, __builtin_amdgcn_ds_bpermute(src << 2, __builtin_bit_cast(int, v))); }
__device__ __forceinline__ float wave_sum(float v, int lane) {
#pragma unroll
    for (int o = 1; o < 64; o <<= 1) v += shx(v, o, lane);
    return v;
}
__device__ __forceinline__ float sigmoidf_(float x) { return __builtin_amdgcn_rcpf(1.0f + __expf(-x)); }
__device__ __forceinline__ float logsigmoidf_(float x) { return fminf(x, 0.f) - __logf(1.0f + __expf(-fabsf(x))); }
#define MFMA16(a, b, c) __builtin_amdgcn_mfma_f32_16x16x32_bf16((a), (b), (c), 0, 0, 0)
#define MFMA32(a, b, c) __builtin_amdgcn_mfma_f32_32x32x16_bf16((a), (b), (c), 0, 0, 0)
__device__ __forceinline__ int lane_id() { int x; asm volatile("v_mbcnt_lo_u32_b32 %0, -1, 0\n\tv_mbcnt_hi_u32_b32 %0, -1, %0" : "=v"(x)); return x; }
__device__ __forceinline__ f32x4 zero4() { float z; asm volatile("v_mov_b32 %0, 0" : "=v"(z)); return (f32x4){z, z, z, z}; }
template <class T> __device__ __forceinline__ T* as_global(T* p) { GAS T* g = (GAS T*)p; asm volatile("" : "+s"(g)); return (T*)g; }
#define XB_TMO      128
#define XB_XCNT(j)  (256  + 64 * (j))
#define XB_XSUB(j)  (1280 + 64 * (j))
#define XB_XGEN(j)  (2304 + 64 * (j))
#define XB_TOP      3328
#define XB_TOPGEN   3392
#define XCD_BAR_WORDS 3456
#define XB_SPIN_CAP (1u << 18)

__device__ __forceinline__ unsigned xb_ld(unsigned* p)              { return __hip_atomic_load(p, __ATOMIC_RELAXED, __HIP_MEMORY_SCOPE_AGENT); }
__device__ __forceinline__ unsigned xb_add(unsigned* p, unsigned v) { return __hip_atomic_fetch_add(p, v, __ATOMIC_RELAXED, __HIP_MEMORY_SCOPE_AGENT); }
__device__ __forceinline__ unsigned xb_xcc_id() { return (unsigned)__builtin_amdgcn_s_getreg((3 << 11) | 20) & 0xFu; }
#define XB_SPIN(cond, bar) do { unsigned _sp = 0; while (cond) { __builtin_amdgcn_s_sleep(1); \
    if ((++_sp & 255u) == 0u) { if (xb_ld(&(bar)[XB_TMO])) break; if (_sp > XB_SPIN_CAP) { atomicAdd(&(bar)[XB_TMO], 1u); break; } } } } while (0)

struct XcdBarrier {
    unsigned* bar; unsigned x;
    volatile LAS unsigned* st;
};

__device__ __forceinline__ XcdBarrier xcd_barrier_post(unsigned* bar, volatile LAS unsigned* st, int wave) {
    XcdBarrier b; b.bar = bar; b.x = xb_xcc_id(); b.st = st;
    if (wave == 0 && lane_id() == 0) (void)xb_add(&bar[XB_XCNT(b.x)], 1u);
    return b;
}
__device__ __forceinline__ void xcd_barrier_complete(unsigned* bar, unsigned x, unsigned& nloc, unsigned& nx) {
    const unsigned G = gridDim.x * gridDim.y * gridDim.z;
    unsigned sum, cnt, mine, sp = 0u;
    for (;;) {
        sum = 0u; cnt = 0u; mine = 0u;
#pragma unroll
        for (unsigned j = 0; j < 16; ++j) { const unsigned c = xb_ld(&bar[XB_XCNT(j)]); sum += c; cnt += (c > 0u) ? 1u : 0u; mine = (j == x) ? c : mine; }
        if (sum == G) break;
        __builtin_amdgcn_s_sleep(1);
        if ((++sp & 255u) == 0u) { if (xb_ld(&bar[XB_TMO])) break; if (sp > XB_SPIN_CAP) { atomicAdd(&bar[XB_TMO], 1u); break; } }
    }
    nloc = mine > 0u ? mine : 1u; nx = cnt > 0u ? cnt : 1u;
}

__device__ __forceinline__ void xcd_barrier(const XcdBarrier& b, int wave) {
    asm volatile("s_waitcnt vmcnt(0)" ::: "memory");
    __syncthreads();
    if (wave == 0 && lane_id() == 0) {
        unsigned* bar = b.bar; asm volatile("" : "+s"(bar));
        __builtin_amdgcn_s_waitcnt(0);
        unsigned nloc = b.st[0], nx = b.st[1];
        if (nloc == 0u) { xcd_barrier_complete(bar, b.x, nloc, nx); b.st[0] = nloc; b.st[1] = nx; }
        const unsigned old = xb_add(&bar[XB_XSUB(b.x)], 1u);
        const unsigned gen = old / nloc;
        if (old + 1u == (gen + 1u) * nloc) {
            __builtin_amdgcn_fence(__ATOMIC_RELEASE, "agent");
            asm volatile("s_waitcnt vmcnt(0)" ::: "memory");
            const unsigned og = xb_add(&bar[XB_TOP], 1u);
            const unsigned tg = og / nx;
            if (og + 1u == (tg + 1u) * nx) xb_add(&bar[XB_TOPGEN], 1u);
            else XB_SPIN(xb_ld(&bar[XB_TOPGEN]) == tg, bar);
            __builtin_amdgcn_fence(__ATOMIC_ACQUIRE, "agent");
            xb_add(&bar[XB_XGEN(b.x)], 1u);
            asm volatile("s_waitcnt vmcnt(0)" ::: "memory");
        } else {
            XB_SPIN(xb_ld(&bar[XB_XGEN(b.x)]) == gen, bar);
            __builtin_amdgcn_fence(__ATOMIC_ACQUIRE, "agent");
            asm volatile("s_waitcnt vmcnt(0)" ::: "memory");
        }
    }
    __syncthreads();
}

struct Args { const float* in[23]; float* out; unsigned char* ws; };
typedef const __attribute__((address_space(4))) Args CArgs;
enum { I_X = 0, I_EV_WIN, I_EV_GW2, I_EV_GB2, I_EV_GNORM, I_EV_WOUT, I_OD_WIN, I_OD_CONVW, I_OD_CONVB, I_OD_WQ, I_OD_WK, I_OD_WV, I_OD_WGATE, I_OD_BGATE,
       I_OD_SKIP, I_OD_NORM, I_OD_WOUT, I_LN1G, I_LN1B, I_LN2G, I_LN2B, I_W1, I_W2 };
struct Frame { int wave, vcu, G; CArgs* ap; };
#ifndef PROBE_GA
#define PROBE_GA (-1)
#define PROBE_GB (-1)
#endif
#ifndef PROBE_DLY
#define PROBE_DLY (-1)
#endif
#define STAMP(grp) do { if (PROBE_GA >= 0 || PROBE_DLY >= 0) { if (F.wave == 0 && lane_id() == 0) { volatile LAS unsigned* mz_ = (volatile LAS unsigned*)(lds_base() + MISC_OFF); const unsigned t_ = (unsigned)__builtin_amdgcn_s_memrealtime(); const unsigned el_ = t_ - mz_[31]; mz_[32 + (grp)] += el_; \
    if (PROBE_DLY == (grp)) { while ((unsigned)__builtin_amdgcn_s_memrealtime() - t_ < el_) __builtin_amdgcn_s_sleep(8); } mz_[31] = (unsigned)__builtin_amdgcn_s_memrealtime(); } } } while (0)
__device__ __forceinline__ int opq_v(int x) { asm volatile("" : "+v"(x)); return x; }
__device__ __forceinline__ int opq_s(int x) { asm volatile("" : "+s"(x)); return x; }
__device__ __forceinline__ LAS unsigned char* lds_base() { extern __shared__ __attribute__((aligned(16))) unsigned char lds_raw[]; return (LAS unsigned char*)lds_raw; }
__device__ __forceinline__ CArgs* opq_p(CArgs* p) { asm volatile("" : "+s"(p)); return p; }
__device__ __forceinline__ LAS unsigned char* opq_l(LAS unsigned char* p) { asm volatile("" : "+s"(p)); return p; }
#define PHASE_UNIFORMS() const int wave = opq_s(F.wave), vcu = opq_s(F.vcu), G = opq_s(F.G), bid = opq_s((int)blockIdx.x); (void)wave; (void)vcu; (void)G; (void)bid

__device__ __forceinline__ void transpose_item(const float* W, int K, int Ns, bf16* WT, int k0, int n0, int sc0, int valid, LAS float* scr, int lane, const float* gk = nullptr) {
    const int c = lane & 31;
    const int cs = c < valid ? c : 0;
    if (gk) {
#pragma unroll 16
        for (int i = 0; i < 32; ++i) { const int kk = 2 * i + (lane >> 5); const float v = W[(size_t)(k0 + kk) * Ns + sc0 + cs] * gk[k0 + kk]; scr[kk * 33 + c] = (c < valid) ? v : 0.f; }
    } else {
#pragma unroll 16
    for (int i = 0; i < 32; ++i) { const int kk = 2 * i + (lane >> 5); const float v = W[(size_t)(k0 + kk) * Ns + sc0 + cs]; scr[kk * 33 + c] = (c < valid) ? v : 0.f; }
    }
    LDS_WAIT(); asm volatile("" ::: "memory");
    const int c8 = lane & 7;
#pragma unroll
    for (int j = 0; j < 4; ++j) { const int n = (lane >> 3) + 8 * j; const LAS float* s = scr + (8 * c8) * 33 + n;
        v4u o; o.x = pk2(s[0 * 33], s[1 * 33]); o.y = pk2(s[2 * 33], s[3 * 33]); o.z = pk2(s[4 * 33], s[5 * 33]); o.w = pk2(s[6 * 33], s[7 * 33]);
        *(GAS v4u*)(WT + (size_t)(n0 + n) * K + k0 + 8 * c8) = o; }
    LDS_WAIT(); asm volatile("" ::: "memory");
}
__device__ __forceinline__ void ev_group(int nb, int& src, int& valid) {
    const int c0 = nb * 32; valid = 32;
    if (c0 < EC_GR) src = 0 + c0;
    else if (c0 < EC_GQ) src = 2760 + (c0 - EC_GR);
    else if (c0 < EC_GK) src = 1224 + (c0 - EC_GQ);
    else if (c0 < EC_GV) src = 1736 + (c0 - EC_GK);
    else if (c0 < EC_IQ) src = 2248 + (c0 - EC_GV);
    else if (c0 < EC_AK) src = 640 + (c0 - EC_IQ);
    else if (c0 < EC_AV) src = 512 + (c0 - EC_AK);
    else if (c0 < EC_IK) src = 576 + (c0 - EC_AV);
    else if (c0 < EC_IW) src = 1152 + (c0 - EC_IK);
    else if (c0 < EC_GLR) { src = 1216; valid = 8; }
    else { src = 3272; valid = 16; }
}
__device__ __forceinline__ void convert_layer(const Frame& F, int l, int parts) {
    CArgs* ap = opq_p(F.ap); unsigned char* ws = as_global(ap->ws);
    PHASE_UNIFORMS(); const int lane = opq_v(lane_id());
    LAS float* scr = (LAS float*)(opq_l(lds_base()) + wave * 16384);
    const int gw = vcu * NWAVES + wave, NGW = G * NWAVES;
    const int j = l >> 1; const bool even = (l & 1) == 0;
    bf16* WIN = (bf16*)(ws + WS_WIN); bf16* WOUT = (bf16*)(ws + WS_WOUT); bf16* W1 = (bf16*)(ws + WS_W1); bf16* W2 = (bf16*)(ws + WS_W2);
    const float* g_in = l > 0 ? as_global(ap->in[I_LN2G]) + (size_t)(l - 1) * DM : nullptr; const float* g_1 = as_global(ap->in[I_LN1G]) + (size_t)l * DM;
    const int n_in = (parts & 1) ? (even ? 16 * (EVW / 32) : 16 * (4096 / 32)) : 0;
    const int n_out = (parts & 2) ? (even ? 16 * 32 : 32 * 32) : 0;
    const int n_1 = (parts & 2) ? 16 * 128 : 0, n_2 = (parts & 2) ? 64 * 32 : 0;
    const int total = n_in + n_out + n_1 + n_2;
    for (int it = gw; it < total; it += NGW) {
        int r = it;
        if (r < n_in) {
            if (even) { const int nblk = EVW / 32, kb = r / nblk, nb = r % nblk; int src, valid; ev_group(nb, src, valid);
                transpose_item(as_global(ap->in[I_EV_WIN]) + (size_t)j * 1024 * EV_SRCW, 1024, EV_SRCW, WIN, 64 * kb, 32 * nb, src, valid, scr, lane, g_in); }
            else { const int nblk = 128, kb = r / nblk, nb = r % nblk;
                transpose_item(as_global(ap->in[I_OD_WIN]) + (size_t)j * 1024 * 4096, 1024, 4096, WIN, 64 * kb, 32 * nb, 32 * nb, 32, scr, lane, g_in); }
            continue; }
        r -= n_in;
        if (r < n_out) { const int kb = r / 32, nb = r % 32;
            if (even) transpose_item(as_global(ap->in[I_EV_WOUT]) + (size_t)j * 1024 * 1024, 1024, 1024, WOUT, 64 * kb, 32 * nb, 32 * nb, 32, scr, lane);
            else transpose_item(as_global(ap->in[I_OD_WOUT]) + (size_t)j * 2048 * 1024, 2048, 1024, WOUT, 64 * kb, 32 * nb, 32 * nb, 32, scr, lane);
            continue; }
        r -= n_out;
        if (r < n_1) { const int kb = r / 128, nb = r % 128; transpose_item(as_global(ap->in[I_W1]) + (size_t)l * 1024 * 4096, 1024, 4096, W1, 64 * kb, 32 * nb, 32 * nb, 32, scr, lane, g_1); continue; }
        r -= n_1;
        { const int kb = r / 32, nb = r % 32; transpose_item(as_global(ap->in[I_W2]) + (size_t)l * 4096 * 1024, 4096, 1024, W2, 64 * kb, 32 * nb, 32 * nb, 32, scr, lane); }
    }
}
__device__ __forceinline__ void colsum_items(const Frame& F, int l, int which) {
    CArgs* ap = opq_p(F.ap); unsigned char* ws = as_global(ap->ws); LAS float* part = (LAS float*)opq_l(lds_base());
    PHASE_UNIFORMS(); const int lane = opq_v(lane_id());
    const int j = l >> 1; const bool even = (l & 1) == 0;
    const float* g; const float* b; const float* W; int Ns, ncol;
    if (which == 0) { g = as_global(ap->in[I_LN2G]) + (size_t)(l - 1) * DM; b = as_global(ap->in[I_LN2B]) + (size_t)(l - 1) * DM;
        if (even) { W = as_global(ap->in[I_EV_WIN]) + (size_t)j * 1024 * EV_SRCW; Ns = EV_SRCW; ncol = EVW; } else { W = as_global(ap->in[I_OD_WIN]) + (size_t)j * 1024 * 4096; Ns = 4096; ncol = 4096; } }
    else { g = as_global(ap->in[I_LN1G]) + (size_t)l * DM; b = as_global(ap->in[I_LN1B]) + (size_t)l * DM; W = as_global(ap->in[I_W1]) + (size_t)l * 1024 * 4096; Ns = 4096; ncol = 4096; }
    float* CS = (float*)(ws + WS_SMALL + SM_COLV) + (which ? 2 * 4096 : 0); float* BB = CS + 4096;
    const int slot = which ? (vcu + G / 2) % G : vcu;
    for (int it = G - 1 - slot; it < ncol / 64; it += G) {
        const int n = 64 * it + lane; int src = n, valid = 32;
        if (which == 0 && even) { ev_group(n >> 5, src, valid); src += (lane & 31) < valid ? (lane & 31) : 0; }
        const bool ok = (lane & 31) < valid;
        const GAS float* wp = (const GAS float*)W + (size_t)(128 * wave) * Ns + src;
        float cs = 0.f, bb = 0.f;
        float wv[128];
#pragma unroll
        for (int kk = 0; kk < 128; ++kk) wv[kk] = wp[(size_t)kk * Ns];
        asm volatile("" ::: "memory"); __builtin_amdgcn_sched_barrier(0);
#pragma unroll
        for (int kk = 0; kk < 128; ++kk) { const float v = wv[kk]; const float gk = g[128 * wave + kk], bk = b[128 * wave + kk];
            const float p = v * gk; cs += bf2f((unsigned short)f2bf(p)); bb += bk * v; }
        __syncthreads();
        part[(wave * 64 + lane) * 2] = ok ? cs : 0.f; part[(wave * 64 + lane) * 2 + 1] = ok ? bb : 0.f;
        __syncthreads();
        if (wave == 0) { float c = 0.f, d = 0.f;
#pragma unroll
            for (int w = 0; w < NWAVES; ++w) { c += part[(w * 64 + lane) * 2]; d += part[(w * 64 + lane) * 2 + 1]; }
            CS[n] = c; BB[n] = d; }
        __syncthreads();
    }
}
__device__ __forceinline__ void fold_small(const Frame& F) {
    CArgs* ap = opq_p(F.ap); unsigned char* ws = as_global(ap->ws);
    PHASE_UNIFORMS(); const int gt = (vcu * NWAVES + wave) * 64 + opq_v(lane_id()), NT = G * NWAVES * 64;
    float* GW = (float*)(ws + WS_SMALL + SM_GATEW); float* KF = (float*)(ws + WS_SMALL + SM_KFOLD);
    for (int i = gt; i < 2 * 2048 * 8; i += NT) {
        const int j = i / (2048 * 8), ch = (i / 8) % 2048, g = i % 8, n = ch >> 2, d = ch & 3;
        const float* wq = as_global(ap->in[I_OD_WQ]) + ((size_t)j * 512 + n) * 16 + d * 4; const float* wk = as_global(ap->in[I_OD_WK]) + ((size_t)j * 512 + n) * 16 + d * 4; const float* wv = as_global(ap->in[I_OD_WV]) + ((size_t)j * 512 + n) * 16 + d * 4;
        const float* wg = as_global(ap->in[I_OD_WGATE]) + (size_t)j * 6144 * 8;
        float sc = 0.f, sm = 0.f;
#pragma unroll
        for (int e = 0; e < 4; ++e) { sc += wq[e] * wg[(size_t)(4 * n + e) * 8 + g] + wk[e] * wg[(size_t)(2048 + 4 * n + e) * 8 + g]; sm += wv[e] * wg[(size_t)(4096 + 4 * n + e) * 8 + g]; }
        GW[((size_t)j * 2 + 0) * 2048 * 8 + ch * 8 + g] = sc; GW[((size_t)j * 2 + 1) * 2048 * 8 + ch * 8 + g] = sm;
    }
    { bf16* W2T = (bf16*)(ws + WS_SMALL + (10 * MiB + 512 * 1024));
      for (int i = gt; i < 2 * 512 * 16; i += NT) { const int j = i / (512 * 16), d = (i / 16) % 512, r = i % 16; W2T[i] = (bf16)f2bf(as_global(ap->in[I_EV_GW2])[((size_t)j * 16 + r) * 512 + d]); } }
    { bf16* GWT = (bf16*)(ws + WS_SMALL + SM_GWT);
      for (int i = gt; i < 2 * 16 * 4096; i += NT) { const int j = i / (16 * 4096), rr = i % (16 * 4096), ksf = rr >> 9, ln = (rr >> 3) & 63, g = ln & 15, ch = 32 * ksf + 8 * (ln >> 4) + (rr & 7); float v = 0.f;
          if (g < 8) { const int n = (ch & 2047) >> 2, d = ch & 3; const float* wg = as_global(ap->in[I_OD_WGATE]) + (size_t)j * 6144 * 8;
              if (ch < 2048) { const float* wq = as_global(ap->in[I_OD_WQ]) + ((size_t)j * 512 + n) * 16 + d * 4; const float* wk = as_global(ap->in[I_OD_WK]) + ((size_t)j * 512 + n) * 16 + d * 4;
#pragma unroll
                  for (int e = 0; e < 4; ++e) v += wq[e] * wg[(size_t)(4 * n + e) * 8 + g] + wk[e] * wg[(size_t)(2048 + 4 * n + e) * 8 + g]; }
              else { const float* wv = as_global(ap->in[I_OD_WV]) + ((size_t)j * 512 + n) * 16 + d * 4;
#pragma unroll
                  for (int e = 0; e < 4; ++e) v += wv[e] * wg[(size_t)(4096 + 4 * n + e) * 8 + g]; } }
          GWT[i] = (bf16)f2bf(v); } }
    for (int i = gt; i < 2 * 512 * 16; i += NT) {
        const int j = i / (512 * 16), n = (i / 16) % 512, ii = (i / 4) % 4, d = i % 4;
        const float* wq = as_global(ap->in[I_OD_WQ]) + ((size_t)j * 512 + n) * 16 + d * 4; const float* wk = as_global(ap->in[I_OD_WK]) + ((size_t)j * 512 + n) * 16 + ii * 4;
        float s = 0.f;
#pragma unroll
        for (int e = 0; e < 4; ++e) s += wk[e] * wq[e];
        KF[i] = s * 0.044194173824159216f;
    }
}
__device__ __forceinline__ void copy_ln_vectors(const Frame& F) {
    CArgs* ap = opq_p(F.ap); unsigned char* ws = as_global(ap->ws); PHASE_UNIFORMS(); const int gt = (vcu * NWAVES + wave) * 64 + opq_v(lane_id());
    if (gt < DEPTH * DM) {
#pragma unroll
        for (int kind = 0; kind < 4; ++kind) ((float*)(ws + pg8::LNW_LNV))[kind * DEPTH * DM + gt] = as_global(ap->in[I_LN1G + kind])[gt]; }
}
__device__ __forceinline__ void x_to_bf16(const Frame& F) {
    CArgs* ap = opq_p(F.ap); unsigned char* ws = as_global(ap->ws); const float* x = as_global(ap->in[I_X]);
    PHASE_UNIFORMS(); const int lane = opq_v(lane_id()); const int gw = vcu * NWAVES + wave, NGW = G * NWAVES; bf16* XB = (bf16*)(ws + WS_XB);
    for (int m = gw; m < M; m += NGW) { const GAS f32x4* xr = (const GAS f32x4*)(x + (size_t)m * DM) + lane; GAS unsigned long long* o8 = (GAS unsigned long long*)(XB + (size_t)m * DM) + lane;
#pragma unroll
        for (int j = 0; j < 4; ++j) { const f32x4 v = xr[64 * j]; o8[64 * j] = (unsigned long long)pk2(v.x, v.y) | ((unsigned long long)pk2(v.z, v.w) << 32); } }
}
__device__ __forceinline__ void ln_phase(const Frame& F, int gi, int bi, int l, bool final_out) {
    CArgs* ap = opq_p(F.ap); unsigned char* ws = as_global(ap->ws); const bf16* T = final_out ? (const bf16*)(ws + WS_XB) : (const bf16*)as_global(ap->out); const float* g = as_global(ap->in[gi]) + (size_t)l * DM; const float* b = as_global(ap->in[bi]) + (size_t)l * DM; float* OUT = final_out ? as_global(ap->out) : nullptr;
    PHASE_UNIFORMS(); const int lane = opq_v(lane_id()); const int gw = vcu * NWAVES + wave, NGW = G * NWAVES; bf16* XB = (bf16*)(ws + WS_XB);
    f32x4 gv[4], bv[4];
#pragma unroll
    for (int j = 0; j < 4; ++j) { gv[j] = ((const GAS f32x4*)g)[lane + 64 * j]; bv[j] = ((const GAS f32x4*)b)[lane + 64 * j]; }
    float pscale = 1.f, pspike = 0.f;
    if (PROBE_GA >= 0 && final_out) { const float* pf = (const float*)(ws + WS_CTL) + 2048; pscale = 1.f + __hip_atomic_load(pf, __ATOMIC_RELAXED, __HIP_MEMORY_SCOPE_AGENT); pspike = 100.f * __hip_atomic_load(pf + 1, __ATOMIC_RELAXED, __HIP_MEMORY_SCOPE_AGENT); }
    v2u nx[2][4];
#pragma unroll
    for (int r = 0; r < 2; ++r) { const int m = gw + r * NGW; const GAS v2u* tr = (const GAS v2u*)(T + (size_t)(m < M ? m : 0) * DM) + lane;
#pragma unroll
        for (int j = 0; j < 4; ++j) nx[r][j] = tr[64 * j]; }
    for (int m0 = gw; m0 < M; m0 += 2 * NGW) {
        v2u cur[2][4];
#pragma unroll
        for (int r = 0; r < 2; ++r)
#pragma unroll
            for (int j = 0; j < 4; ++j) cur[r][j] = nx[r][j];
#pragma unroll
        for (int r = 0; r < 2; ++r) { const int m = m0 + (2 + r) * NGW; const GAS v2u* tr = (const GAS v2u*)(T + (size_t)(m < M ? m : 0) * DM) + lane;
#pragma unroll
            for (int j = 0; j < 4; ++j) nx[r][j] = tr[64 * j]; }
        f32x4 v[2][4]; float s[2] = {0.f, 0.f};
#pragma unroll
        for (int r = 0; r < 2; ++r)
#pragma unroll
            for (int j = 0; j < 4; ++j) { const v2u t = cur[r][j]; v[r][j] = (f32x4){bflo(t.x), bfhi(t.x), bflo(t.y), bfhi(t.y)}; s[r] += (v[r][j].x + v[r][j].y) + (v[r][j].z + v[r][j].w); }
#pragma unroll
        for (int o = 1; o < 64; o <<= 1) { s[0] += shx(s[0], o, lane); s[1] += shx(s[1], o, lane); }
        float s2[2] = {0.f, 0.f};
#pragma unroll
        for (int r = 0; r < 2; ++r) { const float mean = s[r] * (1.f / DM);
#pragma unroll
            for (int j = 0; j < 4; ++j) { v[r][j] = v[r][j] - mean; s2[r] += (v[r][j].x * v[r][j].x + v[r][j].y * v[r][j].y) + (v[r][j].z * v[r][j].z + v[r][j].w * v[r][j].w); } }
#pragma unroll
        for (int o = 1; o < 64; o <<= 1) { s2[0] += shx(s2[0], o, lane); s2[1] += shx(s2[1], o, lane); }
#pragma unroll
        for (int r = 0; r < 2; ++r) { const int m = m0 + r * NGW; if (m < M) { const float rstd = 1.f / sqrtf(s2[r] * (1.f / DM) + LN_EPS);
            GAS unsigned long long* o8 = (GAS unsigned long long*)(XB + (size_t)m * DM) + lane;
#pragma unroll
            for (int j = 0; j < 4; ++j) { const f32x4 y = v[r][j] * rstd * gv[j] + bv[j]; if (!final_out) o8[64 * j] = (unsigned long long)pk2(y.x, y.y) | ((unsigned long long)pk2(y.z, y.w) << 32);
                if (OUT) { f32x4 yo = y * pscale; if (PROBE_GA >= 0 && m == 0 && j == 0 && lane == 0) yo.x += pspike; ((GAS f32x4*)(OUT + (size_t)m * DM))[lane + 64 * j] = yo; } } } }
    }
}
typedef short v4i16_t __attribute__((ext_vector_type(4)));
__device__ __forceinline__ s16x4 tr4(const LAS unsigned char* p) { return __builtin_bit_cast(s16x4, __builtin_amdgcn_ds_read_tr16_b64_v4i16((LAS v4i16_t*)p)); }
__device__ __forceinline__ bf16x8 tr_frag(const LAS unsigned char* T, int pitch, int k0, int n0, int lane) {
    const int g = lane >> 4, q = (lane & 15) >> 2, p = lane & 3;
    const LAS unsigned char* a = T + (k0 + 8 * g + q) * pitch + (n0 + 4 * p) * 2;
    const s16x4 lo = tr4(a), hi = tr4(a + 4 * pitch);
    return (bf16x8){lo[0], lo[1], lo[2], lo[3], hi[0], hi[1], hi[2], hi[3]};
}
__device__ __forceinline__ void lds_fadd(LAS float* p, float v) { (void)__hip_atomic_fetch_add(p, v, __ATOMIC_RELAXED, __HIP_MEMORY_SCOPE_WORKGROUP); }

__device__ __forceinline__ size_t xct_frag(size_t tb16, int cb) { return (tb16 * 64 + (size_t)cb) * 512; }
__device__ __forceinline__ size_t xct_elem(size_t m, int ch) { return ((m >> 4) * 64 + (size_t)(ch >> 5)) * 512 + (size_t)((((ch >> 3) & 3) * 16 + (int)(m & 15)) * 8 + (ch & 7)); }
__device__ __forceinline__ void o2_conv(const Frame& F, int j) {
    CArgs* ap = opq_p(F.ap); unsigned char* ws = as_global(ap->ws); LAS unsigned char* lds = opq_l(lds_base()); PHASE_UNIFORMS();
    const int lane = opq_v(lane_id()), tid = wave * 64 + lane, g4 = lane >> 4, l15 = lane & 15;
    bf16* XM = (bf16*)(ws + WS_BIG); bf16* XC = XM + (size_t)M * MI; bf16* KT = XC + (size_t)M * MI;
    const float* cw = as_global(ap->in[I_OD_CONVW]) + (size_t)j * 4 * MI; const float* cb = as_global(ap->in[I_OD_CONVB]) + (size_t)j * MI;
    const float* KF = (const float*)(ws + WS_SMALL + SM_KFOLD) + (size_t)j * 512 * 16;
    const bf16* GWT = (const bf16*)(ws + WS_SMALL + SM_GWT) + (size_t)j * 16 * 4096;
    const float* bg = as_global(ap->in[I_OD_BGATE]) + j * 8;
    float* LI = (float*)(ws + WS_SMALL + SM_LI); float* BC = (float*)(ws + WS_SMALL + SM_BC); float* CHG = (float*)(ws + WS_SMALL + SM_CHG);
    const int n = tid, ch0 = 4 * n, hh = n >> 7, dd0 = 4 * (n & 127);
    float w[4][4], cbv[4], kf[16];
#pragma unroll
    for (int k = 0; k < 4; ++k)
#pragma unroll
        for (int c = 0; c < 4; ++c) w[k][c] = cw[k * MI + ch0 + c];
#pragma unroll
    for (int c = 0; c < 4; ++c) cbv[c] = cb[ch0 + c];
#pragma unroll
    for (int i = 0; i < 16; ++i) kf[i] = KF[n * 16 + i];
    LAS unsigned char* Xl = lds;
    LAS unsigned char* Xml = lds + 65792;
    LAS float* gpart = (LAS float*)(lds + 131584);
    LAS float* gat = (LAS float*)(lds + 139776);
    bf16x8 Bg0[8];
#pragma unroll
    for (int k8 = 0; k8 < 8; ++k8) Bg0[k8] = *(const bf16x8*)(GWT + ((size_t)(8 * wave + k8) * 64 + lane) * 8);
    for (int u = bid; u < BATCH * NCH; u += G) {
        const int b = u >> 6, c = u & 63, t0 = c * MCH; const size_t m0 = (size_t)b * SEQ + t0;
        float p3[4], p2[4], p1[4];
        { uint2 r3 = make_uint2(0u, 0u), r2 = r3, r1 = r3;
          if (c > 0) { r3 = *(const uint2*)(XM + (m0 - 3) * MI + ch0); r2 = *(const uint2*)(XM + (m0 - 2) * MI + ch0); r1 = *(const uint2*)(XM + (m0 - 1) * MI + ch0); }
          p3[0] = bflo(r3.x); p3[1] = bfhi(r3.x); p3[2] = bflo(r3.y); p3[3] = bfhi(r3.y);
          p2[0] = bflo(r2.x); p2[1] = bfhi(r2.x); p2[2] = bflo(r2.y); p2[3] = bfhi(r2.y);
          p1[0] = bflo(r1.x); p1[1] = bfhi(r1.x); p1[2] = bflo(r1.y); p1[3] = bfhi(r1.y); }
        uint2 nxt[8];
#pragma unroll
        for (int i = 0; i < 8; ++i) nxt[i] = *(const uint2*)(XM + (m0 + i) * MI + ch0);
        for (int tb = 0; tb < 8; ++tb) {
            uint2 raw[8];
#pragma unroll
            for (int i = 0; i < 8; ++i) raw[i] = nxt[i];
            { const int tn = tb < 7 ? tb + 1 : tb;
#pragma unroll
              for (int i = 0; i < 8; ++i) nxt[i] = *(const uint2*)(XM + (m0 + 8 * tn + i) * MI + ch0); }
            float kq[4][8];
#pragma unroll
            for (int i = 0; i < 8; ++i) {
                float x0[4] = {bflo(raw[i].x), bfhi(raw[i].x), bflo(raw[i].y), bfhi(raw[i].y)}, xc[4];
#pragma unroll
                for (int cc = 0; cc < 4; ++cc) { const float z = w[0][cc] * p3[cc] + w[1][cc] * p2[cc] + w[2][cc] * p1[cc] + w[3][cc] * x0[cc] + cbv[cc]; xc[cc] = z * sigmoidf_(z); }
                *(LAS v2u*)(Xl + (8 * (tb & 1) + i) * 4112 + ch0 * 2) = (v2u){pk2(xc[0], xc[1]), pk2(xc[2], xc[3])};
                *(LAS v2u*)(Xml + (8 * (tb & 1) + i) * 4112 + ch0 * 2) = (v2u){raw[i].x, raw[i].y};
#pragma unroll
                for (int d = 0; d < 4; ++d) kq[d][i] = xc[0] * kf[0 * 4 + d] + xc[1] * kf[1 * 4 + d] + xc[2] * kf[2 * 4 + d] + xc[3] * kf[3 * 4 + d];
#pragma unroll
                for (int cc = 0; cc < 4; ++cc) { p3[cc] = p2[cc]; p2[cc] = p1[cc]; p1[cc] = x0[cc]; }
            }
#pragma unroll
            for (int d = 0; d < 4; ++d) { v4u o; o.x = pk2(kq[d][0], kq[d][1]); o.y = pk2(kq[d][2], kq[d][3]); o.z = pk2(kq[d][4], kq[d][5]); o.w = pk2(kq[d][6], kq[d][7]);
                *(v4u*)(KT + (size_t)((b * MH + hh) * NCH + c) * MDH * MCH + ((((dd0 + d) >> 4) * 2 + (tb >> 2)) * 64 + (tb & 3) * 16 + ((dd0 + d) & 15)) * 8) = o; }
            if (tb & 1) {
                __syncthreads();
                bf16x8 Bg1[8];
#pragma unroll
                for (int k8 = 0; k8 < 8; ++k8) Bg1[k8] = *(const bf16x8*)(GWT + ((size_t)(64 + 8 * wave + k8) * 64 + lane) * 8);
                asm volatile("" ::: "memory"); __builtin_amdgcn_sched_barrier(0);
                bf16* dst = XC + xct_frag((m0 >> 4) + (tb >> 1), 0);
#pragma unroll
                for (int k8 = 0; k8 < 8; ++k8) { const int p = tid + 512 * k8, cbk = p >> 6, sl = p & 63; *(v4u*)(dst + (size_t)p * 8) = *(const LAS v4u*)(Xl + (sl & 15) * 4112 + (cbk * 32 + 8 * (sl >> 4)) * 2); }
                { f32x4 acc = zero4();
#pragma unroll
                  for (int hf = 0; hf < 2; ++hf)
#pragma unroll
                      for (int k8 = 0; k8 < 8; ++k8) { const bf16x8 A = *(const LAS bf16x8*)((hf ? Xml : Xl) + l15 * 4112 + (256 * wave + 32 * k8 + 8 * g4) * 2);
                          acc = MFMA16(A, hf ? Bg1[k8] : Bg0[k8], acc); }
#pragma unroll
                  for (int i = 0; i < 4; ++i) gpart[(wave * 16 + 4 * g4 + i) * 16 + l15] = acc[i]; }
                __syncthreads();
                if (tid < 128) { const int tk = tid >> 3, g = tid & 7; float s = bg[g];
#pragma unroll
                    for (int w8 = 0; w8 < 8; ++w8) s += gpart[(w8 * 16 + tk) * 16 + g];
                    gat[(16 * (tb >> 1) + tk) * 8 + g] = s; }
            }
        }
        __syncthreads();
        if (wave < MH) { const int hd = wave; const size_t o = (size_t)(b * MH + hd) * SEQ + t0;
            const float li = gat[lane * 8 + hd]; float bc = logsigmoidf_(gat[lane * 8 + 4 + hd]);
#pragma unroll
            for (int of = 1; of < 64; of <<= 1) { const float v = shi(bc, lane >= of ? lane - of : lane); if (lane >= of) bc += v; }
            LI[o + lane] = li; BC[o + lane] = bc;
            float mx = li - bc;
#pragma unroll
            for (int of = 1; of < 64; of <<= 1) mx = fmaxf(mx, shx(mx, of, lane));
            const float gtot = shi(bc, 63);
            if (lane == 0) { CHG[((size_t)(b * MH + hd) * NCH + c) * 2 + 0] = gtot; CHG[((size_t)(b * MH + hd) * NCH + c) * 2 + 1] = gtot + mx; } }
        __syncthreads();
    }
}

__device__ __forceinline__ void o3_pphase(const Frame& F) {
    CArgs* ap = opq_p(F.ap); unsigned char* ws = as_global(ap->ws); LAS unsigned char* lds = opq_l(lds_base()); PHASE_UNIFORMS();
    const int lane = opq_v(lane_id()), tid = wave * 64 + lane, g4 = lane >> 4, l15 = lane & 15;
    const bf16* XC = (const bf16*)(ws + WS_BIG) + (size_t)M * MI; const bf16* KT = XC + (size_t)M * MI;
    bf16* Pg = (bf16*)(ws + WS_AUX);
    const float* LI = (const float*)(ws + WS_SMALL + SM_LI); const float* BC = (const float*)(ws + WS_SMALL + SM_BC); const float* CHG = (const float*)(ws + WS_SMALL + SM_CHG);
    float* WIN_ = (float*)(ws + WS_SMALL + SM_WIN); float* DEN = (float*)(ws + WS_SMALL + SM_DEN); float* EMM = (float*)(ws + WS_SMALL + SM_EMM); float* WK = (float*)(ws + WS_SMALL + SM_WK); float* DEC = (float*)(ws + WS_SMALL + SM_DEC);
    LAS unsigned char* KL = lds;
    LAS float* sbt = (LAS float*)(lds + 80 * 1024); LAS float* sli = sbt + 64; LAS float* smt = sbt + 128; LAS float* sden = sbt + 192;
    LAS unsigned char* Pt = lds + 84 * 1024;
    const int mb = wave >> 1;
    bf16x8 Aq[16]; v4u kreg[8]; float gi = 0.f, ai = 0.f, bt = 0.f, li = 0.f;
    { const int u = vcu < BATCH * MH * NCH ? vcu : 0; const int bh = u >> 6, c = u & 63; const size_t m0 = (size_t)(bh >> 2) * SEQ + c * MCH; const bf16* src = KT + (size_t)u * MDH * MCH;
#pragma unroll
      for (int ks = 0; ks < 16; ++ks) Aq[ks] = *(const bf16x8*)(XC + xct_frag((m0 >> 4) + mb, (bh & 3) * 16 + ks) + lane * 8);
#pragma unroll
      for (int i = 0; i < 8; ++i) { const int p = tid + 512 * i; kreg[i] = *(const v4u*)(src + p * 8); }
      if (wave == 0) { gi = CHG[((size_t)bh * NCH + lane) * 2 + 0]; ai = CHG[((size_t)bh * NCH + lane) * 2 + 1]; bt = BC[(size_t)bh * SEQ + c * MCH + lane]; li = LI[(size_t)bh * SEQ + c * MCH + lane]; } }
    for (int u = vcu; u < BATCH * MH * NCH; u += G) {
        const int bh = u >> 6, c = u & 63, b = bh >> 2, h = bh & 3; const size_t m0 = (size_t)b * SEQ + c * MCH; (void)b; (void)h; (void)m0;
        const int un = u + G < BATCH * MH * NCH ? u + G : u, bhn = un >> 6, cn = un & 63; const size_t m0n = (size_t)(bhn >> 2) * SEQ + cn * MCH;
#pragma unroll
        for (int i = 0; i < 8; ++i) { const int p = tid + 512 * i, f = p >> 6, sl = p & 63, row = 16 * (f >> 1) + (sl & 15), s0 = 32 * (f & 1) + 8 * (sl >> 4); *(LAS v4u*)(KL + row * 144 + s0 * 2) = kreg[i]; }
        { const bf16* src = KT + (size_t)un * MDH * MCH;
#pragma unroll
          for (int i = 0; i < 8; ++i) { const int p = tid + 512 * i; kreg[i] = *(const v4u*)(src + p * 8); } }
        if (wave == 0) {
            float pg = gi, pa = ai;
#pragma unroll
            for (int o = 1; o < 64; o <<= 1) { const float g_ = shi(pg, lane >= o ? lane - o : lane), a_ = shi(pa, lane >= o ? lane - o : lane);
                if (lane >= o) { pa = fmaxf(pg + a_, pa); pg = pg + g_; } }
            const float mincl = fmaxf(pg, pa);
            const float m = c > 0 ? shi(mincl, c - 1) : 0.f;
            float pm = li - bt;
#pragma unroll
            for (int o = 1; o < 64; o <<= 1) { const float v = shi(pm, lane >= o ? lane - o : lane); if (lane >= o) pm = fmaxf(pm, v); }
            const float mt = bt + fmaxf(m, pm);
            const float g = shi(bt, 63), pm63 = shi(pm, 63), mnew = g + fmaxf(m, pm63);
            const size_t o = (size_t)bh * SEQ + c * MCH + lane;
            WIN_[o] = __expf(bt + m - mt); EMM[o] = __expf(-mt); WK[o] = __expf(g - bt + li - mnew);
            if (lane == 0) DEC[bh * NCH + c] = __expf(g + m - mnew);
            sbt[lane] = bt; sli[lane] = li; smt[lane] = mt;
            gi = CHG[((size_t)bhn * NCH + lane) * 2 + 0]; ai = CHG[((size_t)bhn * NCH + lane) * 2 + 1]; bt = BC[(size_t)bhn * SEQ + cn * MCH + lane]; li = LI[(size_t)bhn * SEQ + cn * MCH + lane];
        }
        __syncthreads();
        f32x4 acc[2] = {zero4(), zero4()};
#pragma unroll
        for (int ks = 0; ks < 16; ++ks) {
#pragma unroll
            for (int nn = 0; nn < 2; ++nn) { const int nb = 2 * (wave & 1) + nn;
                if (nb <= mb) { const bf16x8 B = tr_frag(KL, 144, 32 * ks, 16 * nb, lane); acc[nn] = MFMA16(Aq[ks], B, acc[nn]); } }
        }
#pragma unroll
        for (int ks = 0; ks < 16; ++ks) Aq[ks] = *(const bf16x8*)(XC + xct_frag((m0n >> 4) + mb, (bhn & 3) * 16 + ks) + lane * 8);
        float rs[4] = {0.f, 0.f, 0.f, 0.f};
#pragma unroll
        for (int nn = 0; nn < 2; ++nn) { const int nb = 2 * (wave & 1) + nn, s = 16 * nb + l15; const float bs = sbt[s], ls = sli[s];
#pragma unroll
            for (int i = 0; i < 4; ++i) { const int t = 16 * mb + 4 * g4 + i; float p = 0.f;
                if (nb <= mb && s <= t) p = __expf(sbt[t] - bs + ls - smt[t]) * acc[nn][i];
                rs[i] += p; *(LAS unsigned short*)(Pt + t * 144 + s * 2) = (unsigned short)f2bf(p); } }
#pragma unroll
        for (int i = 0; i < 4; ++i) { float r = rs[i]; r += shx(r, 1, lane); r += shx(r, 2, lane); r += shx(r, 4, lane); r += shx(r, 8, lane);
            if (l15 == 0) sden[(wave & 1) * 64 + 16 * mb + 4 * g4 + i] = r; }
        __syncthreads();
        if (tid < 64) DEN[(size_t)bh * SEQ + c * MCH + tid] = sden[tid] + sden[64 + tid];
        *(v4u*)(Pg + ((size_t)u * 64 + (tid >> 3)) * 64 + 8 * (tid & 7)) = *(const LAS v4u*)(Pt + (tid >> 3) * 144 + (tid & 7) * 16);
        __syncthreads();
    }
}

__device__ __forceinline__ void o4_scan(const Frame& F, int j) {
    CArgs* ap = opq_p(F.ap); unsigned char* ws = as_global(ap->ws); LAS unsigned char* lds = opq_l(lds_base()); PHASE_UNIFORMS();
    const int lane = opq_v(lane_id()), tid = wave * 64 + lane, g4 = lane >> 4, l15 = lane & 15;
    bf16* XM = (bf16*)(ws + WS_BIG); const bf16* XC = XM + (size_t)M * MI; const bf16* KT = XC + (size_t)M * MI;
    const bf16* Pg = (const bf16*)(ws + WS_AUX); const bf16* OG = (const bf16*)as_global(ap->out);
    const float* WIN_ = (const float*)(ws + WS_SMALL + SM_WIN); const float* DEN = (const float*)(ws + WS_SMALL + SM_DEN); const float* EMM = (const float*)(ws + WS_SMALL + SM_EMM);
    const float* WK = (const float*)(ws + WS_SMALL + SM_WK); const float* DEC = (const float*)(ws + WS_SMALL + SM_DEC);
    const float* wvp = as_global(ap->in[I_OD_WV]) + (size_t)j * 512 * 16;
    LAS unsigned char* Vl = lds;
    LAS unsigned char* VTl = lds + 9216;
    LAS unsigned char* Pl = lds + 20480;
    LAS unsigned char* Ct = lds + 29696;
    LAS float* Hp = (LAS float*)(lds + 112896);
    LAS float* swin = (LAS float*)(lds + 112896 + 21504); LAS float* sden = swin + 64; LAS float* semm = swin + 128;
    LAS float* Wl = swin + 192;
    LAS float* Hp1 = (LAS float*)(lds + 136192);
    constexpr int CP = 1040, HP = 84;
#define GLD(T, base, off) (*(const GAS T*)((const GAS char*)(base) + (unsigned)(off)))
    const int wr = (wave + (vcu & 7)) & 7;
    const int vs = tid >> 3, ve0 = 8 * (tid & 7), mb = wr >> 1, kh = wr & 1;
    const unsigned xo = (unsigned)(vs * MI + ve0) * 2u, po = (unsigned)(vs * 64 + ve0) * 2u, so4 = (unsigned)vs * 4u, to4 = (unsigned)(tid & 63) * 4u;
    const unsigned qo = (unsigned)((mb * 64 + 8 * kh) * 512 + lane * 8) * 2u,
                    ko = (unsigned)(wr * 8 * 512 + lane * 8) * 2u;
    for (int u = vcu; u < BATCH * MH * 8; u += G) {
        const int bh = u >> 3, es = u & 7, b = bh >> 2, h = bh & 3, col0 = h * MDH + es * 64;
        f32x4 Cacc[4][5];
#pragma unroll
        for (int db = 0; db < 4; ++db)
#pragma unroll
            for (int nb = 0; nb < 5; ++nb) Cacc[db][nb] = zero4();
        { unsigned wo = (unsigned)(tid & 255) * 4u; asm volatile("" : "+v"(wo)); Wl[tid & 255] = GLD(float, wvp + (size_t)(col0 / 4) * 16, wo); }
        const size_t mrow0 = (size_t)b * SEQ, srow0 = (size_t)bh * SEQ;
        unsigned xo0 = xo, po0 = po, so0 = so4, to0 = to4, qo0 = qo;
        asm volatile("" : "+v"(xo0), "+v"(po0), "+v"(so0), "+v"(to0), "+v"(qo0));
        v4u xr = GLD(v4u, XM + mrow0 * MI + col0, xo0), pr = GLD(v4u, Pg + (size_t)(bh * NCH) * 4096, po0);
        float wks = GLD(float, WK + srow0, so0), s_win = 0.f, s_den = 0.f, s_emm = 0.f;
        if (tid < 64) { s_win = GLD(float, WIN_ + srow0, to0); s_den = GLD(float, DEN + srow0, to0); s_emm = GLD(float, EMM + srow0, to0); }
        bf16x8 qf[8];
#pragma unroll
        for (int ks = 0; ks < 8; ++ks) qf[ks] = GLD(bf16x8, XC + xct_frag(mrow0 >> 4, h * 16), qo0 + 1024u * ks);
        __syncthreads();
        for (int c = 0; c < NCH; ++c) {
            const size_t m0 = mrow0 + c * MCH;
            unsigned xo_ = xo, po_ = po, so_ = so4, to_ = to4, qo_ = qo, ko_ = ko;
            asm volatile("" : "+v"(xo_), "+v"(po_), "+v"(so_), "+v"(to_), "+v"(qo_), "+v"(ko_));
            { float x[8] = {bflo(xr.x), bfhi(xr.x), bflo(xr.y), bfhi(xr.y), bflo(xr.z), bfhi(xr.z), bflo(xr.w), bfhi(xr.w)}, v[8];
#pragma unroll
              for (int blk = 0; blk < 2; ++blk) { const LAS f32x4* wv = (const LAS f32x4*)(Wl + (ve0 / 4 + blk) * 16); const f32x4 w0 = wv[0], w1 = wv[1], w2 = wv[2], w3 = wv[3];
#pragma unroll
                  for (int e = 0; e < 4; ++e) v[4 * blk + e] = x[4 * blk + 0] * w0[e] + x[4 * blk + 1] * w1[e] + x[4 * blk + 2] * w2[e] + x[4 * blk + 3] * w3[e]; }
              v4u o; o.x = pk2(v[0], v[1]); o.y = pk2(v[2], v[3]); o.z = pk2(v[4], v[5]); o.w = pk2(v[6], v[7]);
              *(LAS v4u*)(Vl + vs * 144 + ve0 * 2) = o;
              o.x = pk2(wks * v[0], wks * v[1]); o.y = pk2(wks * v[2], wks * v[3]); o.z = pk2(wks * v[4], wks * v[5]); o.w = pk2(wks * v[6], wks * v[7]);
              *(LAS v4u*)(VTl + vs * 176 + ve0 * 2) = o;
              if ((tid & 7) == 0) { unsigned zz; asm volatile("v_mov_b32 %0, 0" : "=v"(zz)); v4u z; z.x = f2bf(wks); z.y = zz; z.z = zz; z.w = zz; *(LAS v4u*)(VTl + vs * 176 + 128) = z; z.x = zz; *(LAS v4u*)(VTl + vs * 176 + 144) = z; }
              *(LAS v4u*)(Pl + vs * 144 + ve0 * 2) = pr;
              if (tid < 64) { swin[tid] = s_win; sden[tid] = s_den; semm[tid] = s_emm; } }
#pragma unroll
            for (int db = 0; db < 4; ++db)
#pragma unroll
                for (int nb = 0; nb < 5; ++nb) *(LAS v2u*)(Ct + (16 * nb + l15) * CP + (16 * (2 * (db & 1) + (g4 >> 1)) + 2 * wr + (db >> 1)) * 16 + 8 * (g4 & 1)) = (v2u){pk2(Cacc[db][nb][0], Cacc[db][nb][1]), pk2(Cacc[db][nb][2], Cacc[db][nb][3])};
            const v4u og = GLD(v4u, OG + m0 * MI + col0, xo_); const float decay = DEC[bh * NCH + c];
            __syncthreads();
            f32x4 acc[5];
#pragma unroll
            for (int nb = 0; nb < 5; ++nb) acc[nb] = zero4();
            { bf16x8 Bq[2][5];
#pragma unroll
              for (int nb = 0; nb < 5; ++nb) Bq[0][nb] = *(const LAS bf16x8*)(Ct + (16 * nb + l15) * CP + (16 * g4 + 8 * kh) * 16);
#pragma unroll
              for (int ks = 0; ks < 8; ++ks) {
                  if (ks < 7) {
#pragma unroll
                      for (int nb = 0; nb < 5; ++nb) Bq[(ks + 1) & 1][nb] = *(const LAS bf16x8*)(Ct + (16 * nb + l15) * CP + (16 * g4 + 8 * kh + ks + 1) * 16); }
                  asm volatile("" ::: "memory"); __builtin_amdgcn_sched_barrier(0);
#pragma unroll
                  for (int nb = 0; nb < 5; ++nb) acc[nb] = MFMA16(qf[ks], Bq[ks & 1][nb], acc[nb]);
                  asm volatile("" ::: "memory"); __builtin_amdgcn_sched_barrier(0); } }
            bf16x8 kf[4][2];
#pragma unroll
            for (int db = 0; db < 4; ++db)
#pragma unroll
                for (int ks = 0; ks < 2; ++ks) kf[db][ks] = GLD(bf16x8, KT + (size_t)(bh * NCH + c) * MDH * MCH, ko_ + 1024u * (2 * db + ks));
            { const int cn = c + 1 < NCH ? c + 1 : c; const size_t mn = mrow0 + cn * MCH, sn = srow0 + cn * MCH;
#pragma unroll
              for (int ks = 0; ks < 8; ++ks) qf[ks] = GLD(bf16x8, XC + xct_frag(mn >> 4, h * 16), qo_ + 1024u * ks);
              xr = GLD(v4u, XM + mn * MI + col0, xo_); pr = GLD(v4u, Pg + (size_t)(bh * NCH + cn) * 4096, po_);
              wks = GLD(float, WK + sn, so_); if (tid < 64) { s_win = GLD(float, WIN_ + sn, to_); s_den = GLD(float, DEN + sn, to_); s_emm = GLD(float, EMM + sn, to_); } }
            { float wi[4];
#pragma unroll
              for (int i = 0; i < 4; ++i) wi[i] = swin[16 * mb + 4 * g4 + i];
#pragma unroll
              for (int nb = 0; nb < 5; ++nb)
#pragma unroll
                  for (int i = 0; i < 4; ++i) acc[nb][i] *= wi[i]; }
            { const bf16x8 A = *(const LAS bf16x8*)(Pl + (16 * mb + l15) * 144 + (32 * kh + 8 * g4) * 2);
#pragma unroll
              for (int nb = 0; nb < 4; ++nb) { const bf16x8 B = tr_frag(Vl, 144, 32 * kh, 16 * nb, lane); acc[nb] = MFMA16(A, B, acc[nb]); } }
            { LAS float* hp = kh ? Hp1 : Hp;
#pragma unroll
              for (int nb = 0; nb < 5; ++nb)
#pragma unroll
                  for (int i = 0; i < 4; ++i) hp[(16 * mb + 4 * g4 + i) * HP + 16 * nb + l15] = acc[nb][i]; }
            __syncthreads();
            { const float dn = (Hp[vs * HP + 64] + Hp1[vs * HP + 64]) + sden[vs], rd = 1.0f / fmaxf(fabsf(dn), semm[vs]);
              const f32x4 h0 = *(const LAS f32x4*)(Hp + vs * HP + ve0) + *(const LAS f32x4*)(Hp1 + vs * HP + ve0), h1 = *(const LAS f32x4*)(Hp + vs * HP + ve0 + 4) + *(const LAS f32x4*)(Hp1 + vs * HP + ve0 + 4);
              v4u o; o.x = pk2(h0[0] * rd * bflo(og.x), h0[1] * rd * bfhi(og.x)); o.y = pk2(h0[2] * rd * bflo(og.y), h0[3] * rd * bfhi(og.y));
              o.z = pk2(h1[0] * rd * bflo(og.z), h1[1] * rd * bfhi(og.z)); o.w = pk2(h1[2] * rd * bflo(og.w), h1[3] * rd * bfhi(og.w));
              *(GAS v4u*)((GAS char*)(XM + m0 * MI + col0) + xo_) = o; }
#pragma unroll
            for (int db = 0; db < 4; ++db)
#pragma unroll
                for (int nb = 0; nb < 5; ++nb) Cacc[db][nb] = Cacc[db][nb] * decay;
            { bf16x8 Bu[2][2];
#pragma unroll
              for (int ks = 0; ks < 2; ++ks) Bu[0][ks] = tr_frag(VTl, 176, 32 * ks, 0, lane);
#pragma unroll
              for (int nb = 0; nb < 5; ++nb) {
                  if (nb < 4) {
#pragma unroll
                      for (int ks = 0; ks < 2; ++ks) Bu[(nb + 1) & 1][ks] = tr_frag(VTl, 176, 32 * ks, 16 * (nb + 1), lane); }
                  asm volatile("" ::: "memory"); __builtin_amdgcn_sched_barrier(0);
#pragma unroll
                  for (int ks = 0; ks < 2; ++ks)
#pragma unroll
                      for (int db = 0; db < 4; ++db) Cacc[db][nb] = MFMA16(kf[db][ks], Bu[nb & 1][ks], Cacc[db][nb]);
                  asm volatile("" ::: "memory"); __builtin_amdgcn_sched_barrier(0); } }
            __syncthreads();
        }
    }
#undef GLD
}

__device__ __forceinline__ void o5_norm(const Frame& F, int j) {
    CArgs* ap = opq_p(F.ap); unsigned char* ws = as_global(ap->ws); LAS unsigned char* lds = opq_l(lds_base()); PHASE_UNIFORMS();
    const int lane = opq_v(lane_id()), tid = wave * 64 + lane, g4 = lane >> 4, l15 = lane & 15; const int gw = vcu * NWAVES + wave, NGW = G * NWAVES;
    bf16* HB = (bf16*)(ws + WS_BIG); const bf16* XC = HB + (size_t)M * MI;
    const float* ng = as_global(ap->in[I_OD_NORM]) + (size_t)j * MI; const float* sk = as_global(ap->in[I_OD_SKIP]) + (size_t)j * MI;
    LAS float* ngl = (LAS float*)lds; LAS float* skl = ngl + MI;
    for (int i = tid; i < MI; i += 512) { ngl[i] = ng[i]; skl[i] = sk[i]; }
    __syncthreads();
    for (int blk = gw; blk < (M / 16) * MH; blk += NGW) {
        const int tb = blk >> 2, h = blk & 3; const size_t m = (size_t)tb * 16 + l15;
        bf16* hrow = HB + m * MI + h * MDH + 8 * g4;
        v4u hq[16], xq[16];
#pragma unroll
        for (int cb = 0; cb < 16; ++cb) { hq[cb] = *(const v4u*)(hrow + 32 * cb); xq[cb] = *(const v4u*)(XC + xct_frag((size_t)tb, h * 16 + cb) + lane * 8); }
        float s = 0.f;
#pragma unroll
        for (int cb = 0; cb < 16; ++cb) s += ((bflo(hq[cb].x) + bfhi(hq[cb].x)) + (bflo(hq[cb].y) + bfhi(hq[cb].y))) + ((bflo(hq[cb].z) + bfhi(hq[cb].z)) + (bflo(hq[cb].w) + bfhi(hq[cb].w)));
        s += shx(s, 16, lane); s += shx(s, 32, lane);
#pragma unroll
        for (int cb = 0; cb < 16; ++cb) asm volatile("" : "+v"(hq[cb].x), "+v"(hq[cb].y), "+v"(hq[cb].z), "+v"(hq[cb].w));
        const float mean = s * (1.f / MDH); float s2 = 0.f;
#pragma unroll
        for (int cb = 0; cb < 16; ++cb) { const float a0 = bflo(hq[cb].x) - mean, a1 = bfhi(hq[cb].x) - mean, a2 = bflo(hq[cb].y) - mean, a3 = bfhi(hq[cb].y) - mean, a4 = bflo(hq[cb].z) - mean, a5 = bfhi(hq[cb].z) - mean, a6 = bflo(hq[cb].w) - mean, a7 = bfhi(hq[cb].w) - mean;
            s2 += ((a0 * a0 + a1 * a1) + (a2 * a2 + a3 * a3)) + ((a4 * a4 + a5 * a5) + (a6 * a6 + a7 * a7)); }
        s2 += shx(s2, 16, lane); s2 += shx(s2, 32, lane);
#pragma unroll
        for (int cb = 0; cb < 16; ++cb) asm volatile("" : "+v"(hq[cb].x), "+v"(hq[cb].y), "+v"(hq[cb].z), "+v"(hq[cb].w));
        const float rstd = 1.f / sqrtf(s2 * (1.f / MDH) + LN_EPS);
#pragma unroll
        for (int cb = 0; cb < 16; ++cb) { const int c0 = h * MDH + 32 * cb + 8 * g4;
            const f32x4 g0 = *(const LAS f32x4*)(ngl + c0), g1 = *(const LAS f32x4*)(ngl + c0 + 4), k0 = *(const LAS f32x4*)(skl + c0), k1 = *(const LAS f32x4*)(skl + c0 + 4);
            const float hv[8] = {bflo(hq[cb].x), bfhi(hq[cb].x), bflo(hq[cb].y), bfhi(hq[cb].y), bflo(hq[cb].z), bfhi(hq[cb].z), bflo(hq[cb].w), bfhi(hq[cb].w)};
            const float xv[8] = {bflo(xq[cb].x), bfhi(xq[cb].x), bflo(xq[cb].y), bfhi(xq[cb].y), bflo(xq[cb].z), bfhi(xq[cb].z), bflo(xq[cb].w), bfhi(xq[cb].w)};
            float y[8];
#pragma unroll
            for (int e = 0; e < 4; ++e) { y[e] = (hv[e] - mean) * rstd * g0[e] + k0[e] * xv[e]; y[4 + e] = (hv[4 + e] - mean) * rstd * g1[e] + k1[e] * xv[4 + e]; }
            v4u ov; ov.x = pk2(y[0], y[1]); ov.y = pk2(y[2], y[3]); ov.z = pk2(y[4], y[5]); ov.w = pk2(y[6], y[7]);
            *(v4u*)(hrow + 32 * cb) = ov; }
    }
}

__device__ __forceinline__ void odd_mixer(const Frame& F, int j, const XcdBarrier& bar) {
    o2_conv(F, j);
    xcd_barrier(bar, F.wave); STAMP(7);
    o3_pphase(F);
    xcd_barrier(bar, F.wave); STAMP(8);
    o4_scan(F, j);
    xcd_barrier(bar, F.wave); STAMP(9);
    o5_norm(F, j);
    xcd_barrier(bar, F.wave); STAMP(10);
}
constexpr size_t EV_LT_OFF = (size_t)M * EVW * 2;
constexpr size_t SM_GD = 9 * MiB;
constexpr size_t SM_W2T = 10 * MiB + 512 * 1024;

__device__ __forceinline__ unsigned mono_key(float f) { const unsigned u = __float_as_uint(f); return (u & 0x80000000u) ? ~u : (u | 0x80000000u); }

template <int B, int N> __device__ __forceinline__ int count_ge16(const unsigned (&k)[N], unsigned cand) {
    unsigned long long m[16];
#pragma unroll
    for (int i = 0; i < 16; ++i) asm volatile("v_cmp_ge_u32_e64 %0, %1, %2" : "=s"(m[i]) : "v"(k[B + i]), "v"(cand));
    __builtin_amdgcn_sched_barrier(0);
    int c = 0;
#pragma unroll
    for (int i = 0; i < 16; ++i) c += __builtin_popcountll(m[i]);
    __builtin_amdgcn_sched_barrier(0);
    return c;
}
template <int B, int N> __device__ __forceinline__ int count_gt16(const unsigned (&k)[N], unsigned cand) {
    unsigned long long m[16];
#pragma unroll
    for (int i = 0; i < 16; ++i) asm volatile("v_cmp_gt_u32_e64 %0, %1, %2" : "=s"(m[i]) : "v"(k[B + i]), "v"(cand));
    __builtin_amdgcn_sched_barrier(0);
    int c = 0;
#pragma unroll
    for (int i = 0; i < 16; ++i) c += __builtin_popcountll(m[i]);
    __builtin_amdgcn_sched_barrier(0);
    return c;
}

__device__ __forceinline__ void e2_tile(const bf16x8 (&Af)[2][4], const float (&wq)[2][2][8], const bf16x8 (&Bf)[4], LAS float* sc, int kt, int l31, int hi, int p0) {
    const int key = 32 * kt + l31;
#pragma unroll
    for (int mb = 0; mb < 2; ++mb) { f32x16 acc;
#pragma unroll
        for (int e = 0; e < 16; ++e) acc[e] = 0.f;
#pragma unroll
        for (int ks = 0; ks < 4; ++ks) acc = MFMA32(Af[mb][ks], Bf[ks], acc);
#pragma unroll
        for (int qq = 0; qq < 2; ++qq) { float s = 0.f;
#pragma unroll
            for (int h = 0; h < 8; ++h) s += wq[mb][qq][h] * fmaxf(acc[8 * qq + h], 0.f);
            const int ql = 4 * mb + 2 * hi + qq;
            sc[ql * 4096 + key] = (key <= p0 + ql) ? s : -__builtin_inff(); } }
}
__device__ __forceinline__ void e2_unit_loads(const bf16* EV, int i, int G, int l31, int hi, bf16x8 (&Af)[2][4], v4u (&wr)[2][2]) {
    const int r = i / G, w = i % G; int b, qt;
    if (G == 256) { b = r >> 1; qt = (r & 1) ? 511 - w : w; } else { b = i >> 9; qt = i & 511; }
    const int p0 = qt * 8; const size_t mb0 = (size_t)b * SEQ;
    const int jj = l31 >> 3, hp = (l31 >> 2) & 1, ii = l31 & 3, ql = (jj >> 1) + 2 * hp, head = 4 * (jj & 1) + ii;
#pragma unroll
    for (int mb = 0; mb < 2; ++mb) { const bf16* qp = EV + (mb0 + p0 + 4 * mb + ql) * EVW + EC_IQ + head * 64 + 8 * hi;
#pragma unroll
        for (int ks = 0; ks < 4; ++ks) Af[mb][ks] = *(const bf16x8*)(qp + 16 * ks);
#pragma unroll
        for (int qq = 0; qq < 2; ++qq) wr[mb][qq] = *(const v4u*)(EV + (mb0 + p0 + 4 * mb + 2 * hi + qq) * EVW + EC_IW); }
}
__device__ __forceinline__ void e2_index_topk(const Frame& F) {
    CArgs* ap = opq_p(F.ap); unsigned char* ws = as_global(ap->ws); LAS unsigned char* lds = opq_l(lds_base()); PHASE_UNIFORMS();
    const int lane = opq_v(lane_id()), tid = wave * 64 + lane, l31 = lane & 31, hi = lane >> 5;
    const bf16* EV = (const bf16*)(ws + WS_BIG);
    unsigned long long* BMK = (unsigned long long*)(ws + WS_AUX);
    LAS float* sc = (LAS float*)lds;
    bf16x8 Afn[2][4]; v4u wrn[2][2];
    e2_unit_loads(EV, bid < BATCH * 512 ? bid : 0, G, l31, hi, Afn, wrn);
#define E2_UNIT(i_, b_, qt_) do { const int r_ = (i_) / G, w_ = (i_) % G; if (G == 256) { (b_) = r_ >> 1; (qt_) = (r_ & 1) ? 511 - w_ : w_; } else { (b_) = (i_) >> 9; (qt_) = (i_) & 511; } } while (0)
    bf16x8 Br[4][4];
    { int b0_, qt0_; E2_UNIT(bid < BATCH * 512 ? bid : 0, b0_, qt0_); const int nkt0 = (qt0_ * 8 + 8 + 31) >> 5; const bf16* kb0 = (const bf16*)(ws + WS_BIG + EV_IKT_OFF) + (size_t)((size_t)b0_ * SEQ >> 5) * 2048 + lane * 8;
#pragma unroll
      for (int u4 = 0; u4 < 2; ++u4) { const int k0 = wave + NWAVES * u4 < nkt0 ? wave + NWAVES * u4 : nkt0 - 1; const bf16* kp = kb0 + (size_t)k0 * 2048;
#pragma unroll
          for (int ks = 0; ks < 4; ++ks) Br[u4][ks] = *(const bf16x8*)(kp + 512 * ks); } }
        for (int i = bid; i < BATCH * 512; i += G) {
        int b, qt; E2_UNIT(i, b, qt);
        const int p0 = qt * 8; const size_t mb0 = (size_t)b * SEQ;
        const int nkt = (p0 + 8 + 31) >> 5, lim = nkt * 32;
        int bn, qtn; E2_UNIT(i + G < BATCH * 512 ? i + G : i, bn, qtn);
        const int nktn = (qtn * 8 + 8 + 31) >> 5; const bf16* kbn = (const bf16*)(ws + WS_BIG + EV_IKT_OFF) + (size_t)((size_t)bn * SEQ >> 5) * 2048 + lane * 8;
        bf16x8 Af[2][4]; float wq[2][2][8];
#pragma unroll
        for (int mb = 0; mb < 2; ++mb) {
#pragma unroll
            for (int ks = 0; ks < 4; ++ks) Af[mb][ks] = Afn[mb][ks];
#pragma unroll
            for (int qq = 0; qq < 2; ++qq) { const v4u wr = wrn[mb][qq];
                wq[mb][qq][0] = bflo(wr.x); wq[mb][qq][1] = bfhi(wr.x); wq[mb][qq][2] = bflo(wr.y); wq[mb][qq][3] = bfhi(wr.y);
                wq[mb][qq][4] = bflo(wr.z); wq[mb][qq][5] = bfhi(wr.z); wq[mb][qq][6] = bflo(wr.w); wq[mb][qq][7] = bfhi(wr.w); } }
        { const bf16* kbase = (const bf16*)(ws + WS_BIG + EV_IKT_OFF) + (size_t)(mb0 >> 5) * 2048 + lane * 8;
#pragma unroll
          for (int u4 = 2; u4 < 4; ++u4) { const int k0 = wave + NWAVES * u4 < nkt ? wave + NWAVES * u4 : nkt - 1; const bf16* kp = kbase + (size_t)k0 * 2048;
#pragma unroll
              for (int ks = 0; ks < 4; ++ks) Br[u4][ks] = *(const bf16x8*)(kp + 512 * ks); }
          for (int kt = wave; kt < nkt || kt == wave; kt += 4 * NWAVES) {
#pragma unroll
              for (int u4 = 0; u4 < 4; ++u4) {
                  asm volatile("" ::: "memory"); __builtin_amdgcn_sched_barrier(0);
                  if (kt + NWAVES * u4 < nkt) e2_tile(Af, wq, Br[u4], sc, kt + NWAVES * u4, l31, hi, p0);
                  { const bool own = kt + NWAVES * (u4 + 4) < nkt;
                    if (own || u4 < 2) {
                    const int kn = own ? kt + NWAVES * (u4 + 4) : (wave + NWAVES * u4 < nktn ? wave + NWAVES * u4 : nktn - 1); const bf16* kp = (own ? kbase : kbn) + (size_t)kn * 2048;
#pragma unroll
                    for (int ks = 0; ks < 4; ++ks) Br[u4][ks] = *(const bf16x8*)(kp + 512 * ks); } }
              }
          } }
        __syncthreads();
        const int qpos = p0 + wave, n = qpos + 1;
        unsigned keys[64];
        { float raw[64];
#pragma unroll
          for (int j = 0; j < 64; ++j) raw[j] = sc[wave * 4096 + 64 * j + lane];
#pragma unroll
          for (int j = 0; j < 64; ++j) keys[j] = (64 * j + lane < lim) ? mono_key(raw[j]) : 0u; }
        __syncthreads();
        e2_unit_loads(EV, i + G < BATCH * 512 ? i + G : i, G, l31, hi, Afn, wrn);
        unsigned long long myword = 0ull;
        if (n <= 256) {
            const int idx0 = 64 * lane;
            const int cnt = n - idx0; myword = cnt >= 64 ? ~0ull : (cnt <= 0 ? 0ull : ((1ull << cnt) - 1ull));
        } else {
            const int nrb = (lim + 1023) >> 10;
            unsigned T = 0u; bool exact = false; int cgt = 0;
            {
#define E2_COUNT(cand_, out_) do { int c_ = count_ge16<0>(keys, (cand_)); if (nrb > 1) c_ += count_ge16<16>(keys, (cand_)); if (nrb > 2) c_ += count_ge16<32>(keys, (cand_)); if (nrb > 3) c_ += count_ge16<48>(keys, (cand_)); (out_) = c_; } while (0)
#define E2_WAVE_RED(v_, op_) do { _Pragma("unroll") for (int o_ = 1; o_ < 64; o_ <<= 1) { const unsigned ot_ = (unsigned)__builtin_amdgcn_ds_bpermute((lane ^ o_) << 2, (int)(v_)); (v_) = op_(ot_, (v_)); } (v_) = (unsigned)__builtin_amdgcn_readfirstlane((int)(v_)); } while (0)
#define E2_UMAX(a_, b_) ((a_) > (b_) ? (a_) : (b_))
#define E2_UMIN(a_, b_) ((a_) < (b_) ? (a_) : (b_))
                unsigned lo, hi; int clo, chi;
                int cp; E2_COUNT(0x80000000u, cp);
                if (cp >= 256) {
                    unsigned km = 0u;
#pragma unroll
                    for (int jj = 0; jj < 16; ++jj) km = E2_UMAX(keys[jj], km);
                    if (nrb > 1) {
#pragma unroll
                        for (int jj = 16; jj < 32; ++jj) km = E2_UMAX(keys[jj], km); }
                    if (nrb > 2) {
#pragma unroll
                        for (int jj = 32; jj < 48; ++jj) km = E2_UMAX(keys[jj], km); }
                    if (nrb > 3) {
#pragma unroll
                        for (int jj = 48; jj < 64; ++jj) km = E2_UMAX(keys[jj], km); }
                    E2_WAVE_RED(km, E2_UMAX);
                    lo = 0x80000000u; clo = cp; hi = km + 1u; chi = 0;
                    bool ok = false; unsigned step = 1u << 23;
                    for (int w = 0; w < 4; ++w) { if (hi - lo <= step) { ok = true; break; } const unsigned Tw = hi - step; int c; E2_COUNT(Tw, c);
                        if (c >= 256) { lo = Tw; clo = c; ok = true; break; }
                        hi = Tw; chi = c; step <<= 1; }
                    if (!ok && hi - lo > 1u) { int c; E2_COUNT(0x80000001u, c);
                        if (c >= 256) { lo = 0x80000001u; clo = c; } else { hi = 0x80000001u; chi = c; } }
                } else {
                    unsigned kn = 0xFFFFFFFFu;
#pragma unroll
                    for (int jj = 0; jj < 16; ++jj) kn = E2_UMIN(keys[jj] - 0x00800000u, kn);
                    if (nrb > 1) {
#pragma unroll
                        for (int jj = 16; jj < 32; ++jj) kn = E2_UMIN(keys[jj] - 0x00800000u, kn); }
                    if (nrb > 2) {
#pragma unroll
                        for (int jj = 32; jj < 48; ++jj) kn = E2_UMIN(keys[jj] - 0x00800000u, kn); }
                    if (nrb > 3) {
#pragma unroll
                        for (int jj = 48; jj < 64; ++jj) kn = E2_UMIN(keys[jj] - 0x00800000u, kn); }
                    E2_WAVE_RED(kn, E2_UMIN);
                    lo = kn + 0x00800000u; clo = n; hi = 0x80000000u; chi = cp;
                    unsigned step = 1u << 23;
                    for (int w = 0; w < 4; ++w) { if (hi - lo <= step) break; const unsigned Tw = lo + step; int c; E2_COUNT(Tw, c);
                        if (c >= 256) { lo = Tw; clo = c; step <<= 1; } else { hi = Tw; chi = c; break; } }
                }
                for (int it = 0; ; ++it) {
                    if (clo == 256) { exact = true; T = lo; break; }
                    if (hi - lo == 1u) { T = lo; break; }
                    unsigned d;
                    if ((it % 3) == 2) d = (hi - lo) >> 1;
                    else { const float f = (float)(clo - 256) / (float)(clo - chi); d = (unsigned)((float)(hi - lo) * f); }
                    d = (unsigned)__builtin_amdgcn_readfirstlane((int)d);
                    d = d < 1u ? 1u : d; if (d > hi - lo - 1u) d = hi - lo - 1u;
                    const unsigned Tp = lo + d; int c; E2_COUNT(Tp, c);
                    if (c >= 256) { lo = Tp; clo = c; } else { hi = Tp; chi = c; }
                }
#undef E2_COUNT
#undef E2_WAVE_RED
#undef E2_UMAX
#undef E2_UMIN
                if (!exact) { cgt = count_gt16<0>(keys, T); if (nrb > 1) cgt += count_gt16<16>(keys, T); if (nrb > 2) cgt += count_gt16<32>(keys, T); if (nrb > 3) cgt += count_gt16<48>(keys, T); }
            }
            if (exact) {
#pragma unroll
                for (int j = 0; j < 64; ++j) { const unsigned long long word = __ballot(keys[j] >= T); if (lane == j) myword = word; }
            } else {
                int need = 256 - cgt;
#pragma unroll
                for (int j = 0; j < 64; ++j) { const unsigned long long gt = __ballot(keys[j] > T), eq = __ballot(keys[j] == T); unsigned long long keep = eq;
                    const int eqc = __popcll(eq); int take = need < eqc ? need : eqc; if (take < 0) take = 0;
                    if (take < eqc) { keep = 0ull; unsigned long long mm = eq; for (int k = 0; k < take; ++k) { const unsigned long long low = mm & (0ull - mm); keep |= low; mm ^= low; } }
                    need -= take;
                    const unsigned long long word = gt | keep;
                    if (lane == j) myword = word; }
            }
        }
        BMK[(mb0 + qpos) * 64 + lane] = myword;
    }
}

__device__ __forceinline__ void e3_attention(const Frame& F) {
    CArgs* ap = opq_p(F.ap); unsigned char* ws = as_global(ap->ws); LAS unsigned char* lds = opq_l(lds_base()); PHASE_UNIFORMS();
    const int lane = opq_v(lane_id()), tid = wave * 64 + lane, l31 = lane & 31, hi = lane >> 5;
    bf16* EV = (bf16*)(ws + WS_BIG);
    const unsigned long long* BMK = (const unsigned long long*)(ws + WS_AUX);
    LAS unsigned char* Kl = lds;
    LAS unsigned char* Vt = lds + 9216;
        constexpr float SC2 = 0.125f * 1.4426950408889634f;
#define E3_UNIT(i_, b_, qt_) do { if (G == 256) { const int k_ = (i_) >> 8, w_ = (i_) & 255; (b_) = 2 * k_ + (w_ >> 7); (qt_) = (k_ & 1) ? 127 - (w_ & 127) : (w_ & 127); } else { (b_) = (i_) >> 7; (qt_) = (i_) & 127; } } while (0)
    const int ql = l31 >> 3, head = l31 & 7, skey = tid >> 3, spc = tid & 7;
    bf16x8 Qfn[4]; v4u kreg, vreg; unsigned long long mword;
    { int b0_, qt0_; E3_UNIT(bid < BATCH * 128 ? bid : 0, b0_, qt0_); const size_t mb00 = (size_t)b0_ * SEQ; const int qpos0 = qt0_ * 32 + 4 * wave + ql; const bf16* qrow0 = EV + (mb00 + qpos0) * EVW + EC_AQ + head * 64;
#pragma unroll
      for (int ks = 0; ks < 4; ++ks) Qfn[ks] = *(const bf16x8*)(qrow0 + 16 * ks + 8 * hi);
      kreg = *(const v4u*)(EV + (mb00 + skey) * EVW + EC_AK + 8 * spc); vreg = *(const v4u*)(EV + (mb00 + skey) * EVW + EC_AV + 8 * spc); mword = BMK[(mb00 + qpos0) * 64 + 0]; }
    for (int i = bid; i < BATCH * 128; i += G) {
        int b, qt; E3_UNIT(i, b, qt);
        const size_t mb0 = (size_t)b * SEQ; const int q0 = qt * 32, nkt = (qt >> 1) + 1;
        const int qpos = q0 + 4 * wave + ql;
        bf16* qrow = EV + (mb0 + qpos) * EVW + EC_AQ + head * 64;
        int bn, qtn; E3_UNIT(i + G < BATCH * 128 ? i + G : i, bn, qtn);
        const size_t mb0n = (size_t)bn * SEQ; const int qposn = qtn * 32 + 4 * wave + ql; const bf16* qrown = EV + (mb0n + qposn) * EVW + EC_AQ + head * 64;
        bf16x8 Qf[4];
#pragma unroll
        for (int ks = 0; ks < 4; ++ks) Qf[ks] = Qfn[ks];
        f32x16 accO[2];
#pragma unroll
        for (int e = 0; e < 16; ++e) { accO[0][e] = 0.f; accO[1][e] = 0.f; }
        float mrun = -__builtin_inff(), lrun = 0.f;
        for (int kt = 0; kt < nkt; ++kt) {
            __syncthreads();
            *(LAS v4u*)(Kl + skey * 144 + spc * 16) = kreg;
            *(LAS v4u*)(Vt + skey * 144 + spc * 16) = vreg;
            const unsigned long long mw = mword;
            __syncthreads();
            if (kt + 1 < nkt) { const size_t kr = mb0 + 64 * (kt + 1) + skey; kreg = *(const v4u*)(EV + kr * EVW + EC_AK + 8 * spc); vreg = *(const v4u*)(EV + kr * EVW + EC_AV + 8 * spc); mword = BMK[(mb0 + qpos) * 64 + kt + 1]; }
            else { kreg = *(const v4u*)(EV + (mb0n + skey) * EVW + EC_AK + 8 * spc); vreg = *(const v4u*)(EV + (mb0n + skey) * EVW + EC_AV + 8 * spc); mword = BMK[(mb0n + qposn) * 64 + 0];
#pragma unroll
                for (int ks = 0; ks < 4; ++ks) Qfn[ks] = *(const bf16x8*)(qrown + 16 * ks + 8 * hi); }
            bf16x8 Kfr[2][4], Vfr[2][2][2];
#pragma unroll
            for (int kb = 0; kb < 2; ++kb)
#pragma unroll
                for (int ks = 0; ks < 4; ++ks) Kfr[kb][ks] = *(const LAS bf16x8*)(Kl + (32 * kb + l31) * 144 + (16 * ks + 8 * hi) * 2);
#pragma unroll
            for (int db = 0; db < 2; ++db)
#pragma unroll
                for (int kb = 0; kb < 2; ++kb)
#pragma unroll
                    for (int s = 0; s < 2; ++s) {
                        const LAS unsigned char* va = Vt + (32 * kb + 16 * s + 4 * hi + ((lane & 15) >> 2)) * 144 + (32 * db + 16 * ((lane >> 4) & 1) + 4 * (lane & 3)) * 2;
                        const s16x4 lo = tr4(va), hi4 = tr4(va + 8 * 144);
                        Vfr[db][kb][s] = (bf16x8){lo[0], lo[1], lo[2], lo[3], hi4[0], hi4[1], hi4[2], hi4[3]}; }
            asm volatile("" ::: "memory"); __builtin_amdgcn_sched_barrier(0);
            f32x16 accS[2];
#pragma unroll
            for (int kb = 0; kb < 2; ++kb) {
#pragma unroll
                for (int e = 0; e < 16; ++e) accS[kb][e] = 0.f;
#pragma unroll
                for (int ks = 0; ks < 4; ++ks) accS[kb] = MFMA32(Kfr[kb][ks], Qf[ks], accS[kb]); }
            float mloc = -__builtin_inff();
#pragma unroll
            for (int kb = 0; kb < 2; ++kb)
#pragma unroll
                for (int e = 0; e < 16; ++e) mloc = fmaxf(mloc, accS[kb][e]);
            mloc = fmaxf(mloc, shx(mloc, 32, lane)) * SC2;
            const float mnew = fmaxf(mrun, mloc);
            const float alpha = __builtin_amdgcn_exp2f(mrun - mnew);
            mrun = mnew;
            const int mwh[2] = {(int)((unsigned)mw >> (4 * hi)), (int)((unsigned)(mw >> 32) >> (4 * hi))};
            bf16x8 Pf[2][2];
            f32x2_t ls2 = {0.f, 0.f}; const f32x2_t sc2 = {SC2, SC2}, nm2 = {-mnew, -mnew};
#pragma unroll
            for (int kb = 0; kb < 2; ++kb) { float p[16];
#pragma unroll
                for (int e = 0; e < 16; e += 2) { const f32x2_t a2 = {accS[kb][e], accS[kb][e + 1]}; const f32x2_t x2 = __builtin_elementwise_fma(a2, sc2, nm2);
                    f32x2_t p2;
#pragma unroll
                    for (int k = 0; k < 2; ++k) { const float pe = __builtin_amdgcn_exp2f(x2[k]);
                        unsigned sel; asm("v_bfe_i32 %0, %1, %2, 1" : "=v"(sel) : "v"(mwh[kb]), "n"(((e + k) & 3) + 8 * ((e + k) >> 2)));
                        p2[k] = __uint_as_float(__float_as_uint(pe) & sel); p[e + k] = p2[k]; }
                    ls2 += p2; }
#pragma unroll
                for (int s = 0; s < 2; ++s) { v4u t; t.x = pk2(p[8 * s + 0], p[8 * s + 1]); t.y = pk2(p[8 * s + 2], p[8 * s + 3]); t.z = pk2(p[8 * s + 4], p[8 * s + 5]); t.w = pk2(p[8 * s + 6], p[8 * s + 7]); Pf[kb][s] = __builtin_bit_cast(bf16x8, t); } }
            lrun = lrun * alpha + (ls2[0] + ls2[1]);
            if (__builtin_amdgcn_ballot_w64(alpha != 1.0f) != 0ull) {
#pragma unroll
                for (int db = 0; db < 2; ++db)
#pragma unroll
                    for (int e = 0; e < 16; ++e) accO[db][e] *= alpha; }
#pragma unroll
            for (int db = 0; db < 2; ++db) {
#pragma unroll
                for (int kb = 0; kb < 2; ++kb)
#pragma unroll
                    for (int s = 0; s < 2; ++s) accO[db] = MFMA32(Vfr[db][kb][s], Pf[kb][s], accO[db]); }
        }
        const float ltot = lrun + shx(lrun, 32, lane), rl = 1.0f / ltot;
#pragma unroll
        for (int db = 0; db < 2; ++db)
#pragma unroll
            for (int g = 0; g < 4; ++g) { const int d = 32 * db + 8 * g + 4 * hi;
                *(uint2*)(qrow + d) = make_uint2(pk2(accO[db][4 * g + 0] * rl, accO[db][4 * g + 1] * rl), pk2(accO[db][4 * g + 2] * rl, accO[db][4 * g + 3] * rl)); }
    }
}

__device__ __forceinline__ void g1_gla_local(const Frame& F, int j) {
    CArgs* ap = opq_p(F.ap); unsigned char* ws = as_global(ap->ws); LAS unsigned char* lds = opq_l(lds_base()); PHASE_UNIFORMS();
    const int lane = opq_v(lane_id()), tid = wave * 64 + lane, g4 = lane >> 4, l15 = lane & 15;
    bf16* EV = (bf16*)(ws + WS_BIG);
    bf16* LT = (bf16*)(ws + WS_BIG + EV_LT_OFF); float* GD = (float*)(ws + WS_SMALL + SM_GD);
    const bf16* w2t = (const bf16*)(ws + WS_SMALL + SM_W2T) + (size_t)j * 512 * 16; const float* b2 = as_global(ap->in[I_EV_GB2]) + (size_t)j * 512;
    LAS float* la = (LAS float*)lds;
    LAS unsigned char* Qt = lds + 32768;
    LAS unsigned char* Kt = Qt + 17408; LAS unsigned char* KE = Kt + 17408; LAS unsigned char* Vl = KE + 17408;
    LAS unsigned char* Pl = Vl + 17408;
    bf16x8 An_, Bn_[4]; float bbn_[4];
#define G1_ZLOADS(u_) do { const int bh_ = (u_) >> 6, c_ = (u_) & 63, b_ = bh_ >> 2, h_ = bh_ & 3; const size_t m0_ = (size_t)b_ * SEQ + c_ * 64; \
        An_ = *(const bf16x8*)(EV + (m0_ + 16 * (wave >> 1) + l15) * EVW + EC_GLR + 8 * (g4 & 1)); \
        _Pragma("unroll") for (int nn_ = 0; nn_ < 4; ++nn_) { const int d_ = 16 * (4 * (wave & 1) + nn_) + l15; Bn_[nn_] = *(const bf16x8*)(w2t + (size_t)(h_ * 128 + d_) * 16 + 8 * (g4 & 1)); bbn_[nn_] = b2[h_ * 128 + d_]; } } while (0)
    G1_ZLOADS(vcu < BATCH * 4 * 64 ? vcu : 0);
    for (int u = vcu; u < BATCH * 4 * 64; u += G) {
        const int bh = u >> 6, c = u & 63, b = bh >> 2, h = bh & 3; const size_t m0 = (size_t)b * SEQ + c * 64;
        const int t = tid >> 3, d0 = 16 * (tid & 7);
        v4u qr[2], kr[2], vr[2];
        { const bf16* qg = EV + (m0 + t) * EVW + EC_GQ + h * 128 + d0;
#pragma unroll
          for (int hf = 0; hf < 2; ++hf) { qr[hf] = *(const v4u*)(qg + 8 * hf); kr[hf] = *(const v4u*)(qg + (EC_GK - EC_GQ) + 8 * hf); vr[hf] = *(const v4u*)(qg + (EC_GV - EC_GQ) + 8 * hf); } }
        { const int mb = wave >> 1; const bf16x8 Z8 = (bf16x8){0, 0, 0, 0, 0, 0, 0, 0};
          bf16x8 A = An_; bf16x8 Bc[4]; float bbc[4];
#pragma unroll
          for (int nn = 0; nn < 4; ++nn) { Bc[nn] = Bn_[nn]; bbc[nn] = bbn_[nn]; }
          G1_ZLOADS(u + G < BATCH * 4 * 64 ? u + G : u);
          asm volatile("" ::: "memory"); __builtin_amdgcn_sched_barrier(0);
          A = g4 < 2 ? A : Z8;
#pragma unroll
          for (int nn = 0; nn < 4; ++nn) { const int nb = 4 * (wave & 1) + nn, d = 16 * nb + l15;
              bf16x8 B = Bc[nn]; B = g4 < 2 ? B : Z8;
              const f32x4 z = MFMA16(A, B, zero4()); const float bb = bbc[nn];
#pragma unroll
              for (int i = 0; i < 4; ++i) la[(16 * mb + 4 * g4 + i) * 128 + d] = logsigmoidf_(z[i] + bb) * (1.0f / 16.0f); } }
        __syncthreads();
        { const int d = tid & 127, seg = tid >> 7; float run = 0.f;
#pragma unroll
          for (int s = 0; s < 16; ++s) { run += la[(16 * seg + s) * 128 + d]; la[(16 * seg + s) * 128 + d] = run; }
          __syncthreads();
          float off = 0.f;
          for (int s2 = 0; s2 < seg; ++s2) off += la[(16 * s2 + 15) * 128 + d];
          __syncthreads();
#pragma unroll
          for (int s = 0; s < 16; ++s) la[(16 * seg + s) * 128 + d] += off; }
        __syncthreads();
        { bf16* qg = EV + (m0 + t) * EVW + EC_GQ + h * 128 + d0;
#pragma unroll
          for (int hf = 0; hf < 2; ++hf) {
              const float qv[8] = {bflo(qr[hf].x), bfhi(qr[hf].x), bflo(qr[hf].y), bfhi(qr[hf].y), bflo(qr[hf].z), bfhi(qr[hf].z), bflo(qr[hf].w), bfhi(qr[hf].w)};
              const float kv[8] = {bflo(kr[hf].x), bfhi(kr[hf].x), bflo(kr[hf].y), bfhi(kr[hf].y), bflo(kr[hf].z), bfhi(kr[hf].z), bflo(kr[hf].w), bfhi(kr[hf].w)};
              const f32x4 b0 = *(const LAS f32x4*)(la + t * 128 + d0 + 8 * hf), b1 = *(const LAS f32x4*)(la + t * 128 + d0 + 8 * hf + 4), g0 = *(const LAS f32x4*)(la + 63 * 128 + d0 + 8 * hf), g1 = *(const LAS f32x4*)(la + 63 * 128 + d0 + 8 * hf + 4);
              const float bcv[8] = {b0[0], b0[1], b0[2], b0[3], b1[0], b1[1], b1[2], b1[3]}, gdv[8] = {g0[0], g0[1], g0[2], g0[3], g1[0], g1[1], g1[2], g1[3]};
              float qt_[8], kt_[8], ke_[8];
#pragma unroll
              for (int e = 0; e < 8; ++e) { qt_[e] = qv[e] * __expf(bcv[e]) * 0.08838834764831845f; kt_[e] = kv[e] * __expf(-bcv[e]); ke_[e] = kv[e] * __expf(gdv[e] - bcv[e]); }
              if (t == 63) { float* gp = GD + ((size_t)bh * 64 + c) * 128 + d0 + 8 * hf;
                  *(f32x4*)gp = (f32x4){__expf(gdv[0]), __expf(gdv[1]), __expf(gdv[2]), __expf(gdv[3])}; *(f32x4*)(gp + 4) = (f32x4){__expf(gdv[4]), __expf(gdv[5]), __expf(gdv[6]), __expf(gdv[7])}; }
              v4u o; o.x = pk2(qt_[0], qt_[1]); o.y = pk2(qt_[2], qt_[3]); o.z = pk2(qt_[4], qt_[5]); o.w = pk2(qt_[6], qt_[7]);
              *(LAS v4u*)(Qt + t * 272 + (d0 + 8 * hf) * 2) = o; *(v4u*)(qg + 8 * hf) = o;
              o.x = pk2(kt_[0], kt_[1]); o.y = pk2(kt_[2], kt_[3]); o.z = pk2(kt_[4], kt_[5]); o.w = pk2(kt_[6], kt_[7]); *(LAS v4u*)(Kt + t * 272 + (d0 + 8 * hf) * 2) = o;
              o.x = pk2(ke_[0], ke_[1]); o.y = pk2(ke_[2], ke_[3]); o.z = pk2(ke_[4], ke_[5]); o.w = pk2(ke_[6], ke_[7]); *(LAS v4u*)(KE + t * 272 + (d0 + 8 * hf) * 2) = o;
              *(LAS v4u*)(Vl + t * 272 + (d0 + 8 * hf) * 2) = vr[hf]; } }
        __syncthreads();
        { const int mb = wave >> 1;
#pragma unroll
          for (int nn = 0; nn < 2; ++nn) { const int nb = 2 * (wave & 1) + nn; f32x4 acc = zero4();
              if (nb <= mb) {
#pragma unroll
                  for (int ks = 0; ks < 4; ++ks) { const bf16x8 A = *(const LAS bf16x8*)(Qt + (16 * mb + l15) * 272 + (32 * ks + 8 * g4) * 2), B = *(const LAS bf16x8*)(Kt + (16 * nb + l15) * 272 + (32 * ks + 8 * g4) * 2); acc = MFMA16(A, B, acc); } }
#pragma unroll
              for (int i = 0; i < 4; ++i) { const int tt = 16 * mb + 4 * g4 + i, s = 16 * nb + l15; *(LAS unsigned short*)(Pl + tt * 144 + s * 2) = (unsigned short)f2bf((nb <= mb && s <= tt) ? acc[i] : 0.f); } } }
        __syncthreads();
        { const int mb = wave >> 1;
#pragma unroll
          for (int nn = 0; nn < 4; ++nn) { const int nb = 4 * (wave & 1) + nn; f32x4 acc = zero4();
#pragma unroll
              for (int ks = 0; ks < 2; ++ks) { const bf16x8 A = *(const LAS bf16x8*)(Pl + (16 * mb + l15) * 144 + (32 * ks + 8 * g4) * 2); const bf16x8 B = tr_frag(Vl, 272, 32 * ks, 16 * nb, lane); acc = MFMA16(A, B, acc); }
#pragma unroll
              for (int i = 0; i < 4; ++i) *(LAS unsigned short*)(Qt + (16 * mb + 4 * g4 + i) * 272 + (16 * nb + l15) * 2) = (unsigned short)f2bf(acc[i]); }
          bf16* lt = LT + (size_t)u * 128 * 128;
#pragma unroll
          for (int nb = 0; nb < 8; ++nb) { f32x4 acc = zero4();
#pragma unroll
              for (int ks = 0; ks < 2; ++ks) { const bf16x8 A = tr_frag(KE, 272, 32 * ks, 16 * wave, lane), B = tr_frag(Vl, 272, 32 * ks, 16 * nb, lane); acc = MFMA16(A, B, acc); }
              *(v2u*)(lt + ((nb * 4 + (wave >> 1)) * 64 + (2 * (wave & 1) + (g4 >> 1)) * 16 + l15) * 8 + 4 * (g4 & 1)) = (v2u){pk2(acc[0], acc[1]), pk2(acc[2], acc[3])}; } }
        __syncthreads();
        { const int t = tid >> 3, d0 = 16 * (tid & 7); bf16* og = EV + (m0 + t) * EVW + EC_GK + h * 128 + d0;
          *(v4u*)og = *(const LAS v4u*)(Qt + t * 272 + d0 * 2); *(v4u*)(og + 8) = *(const LAS v4u*)(Qt + t * 272 + d0 * 2 + 16); }
    }
}
__device__ __forceinline__ void g2_gla_scan(const Frame& F) {
    CArgs* ap = opq_p(F.ap); unsigned char* ws = as_global(ap->ws); PHASE_UNIFORMS(); const int tid = wave * 64 + opq_v(lane_id());
    bf16* LT = (bf16*)(ws + WS_BIG + EV_LT_OFF); const float* GD = (const float*)(ws + WS_SMALL + SM_GD);
    for (int e4 = vcu * 512 + tid; e4 < BATCH * 4 * 4096; e4 += G * 512) {
        const int bh = e4 >> 12, r = e4 & 4095, dk0 = 32 * ((r >> 7) & 3) + 8 * ((r & 127) >> 5) + 4 * (r & 1);
        f32x4 S = zero4();
        for (int c0 = 0; c0 < 64; c0 += 8) { v2u L[8]; f32x4 g[8];
#pragma unroll
            for (int i = 0; i < 8; ++i) { L[i] = *(const v2u*)(LT + ((size_t)(bh * 64 + c0 + i) * 4096 + r) * 4); g[i] = *(const f32x4*)(GD + ((size_t)bh * 64 + c0 + i) * 128 + dk0); }
#pragma unroll
            for (int i = 0; i < 8; ++i) { *(v2u*)(LT + ((size_t)(bh * 64 + c0 + i) * 4096 + r) * 4) = (v2u){pk2(S[0], S[1]), pk2(S[2], S[3])};
                S = g[i] * S + (f32x4){bflo(L[i].x), bfhi(L[i].x), bflo(L[i].y), bfhi(L[i].y)}; } }
    }
}
__device__ __forceinline__ void g3_gla_out(const Frame& F, int j) {
    CArgs* ap = opq_p(F.ap); unsigned char* ws = as_global(ap->ws); LAS unsigned char* lds = opq_l(lds_base()); PHASE_UNIFORMS();
    const int lane = opq_v(lane_id()), tid = wave * 64 + lane, g4 = lane >> 4, l15 = lane & 15;
    bf16* EV = (bf16*)(ws + WS_BIG);
    const bf16* LT = (const bf16*)(ws + WS_BIG + EV_LT_OFF);
    const float* gn = as_global(ap->in[I_EV_GNORM]) + (size_t)j * 512;
    LAS float* ol = (LAS float*)lds;
    const int mb = wave >> 1;
    bf16x8 An[4], Bn[4][4];
    { const int u = vcu < BATCH * 4 * 64 ? vcu : 0; const int bh = u >> 6, c = u & 63, b = bh >> 2, h = bh & 3; const size_t m0 = (size_t)b * SEQ + c * 64; const bf16* st = LT + (size_t)u * 128 * 128;
#pragma unroll
      for (int ks = 0; ks < 4; ++ks) An[ks] = *(const bf16x8*)(EV + (m0 + 16 * mb + l15) * EVW + EC_GQ + h * 128 + 32 * ks + 8 * g4);
#pragma unroll
      for (int nn = 0; nn < 4; ++nn)
#pragma unroll
          for (int ks = 0; ks < 4; ++ks) Bn[nn][ks] = *(const bf16x8*)(st + (((4 * (wave & 1) + nn) * 4 + ks) * 64 + lane) * 8); }
    for (int u = vcu; u < BATCH * 4 * 64; u += G) {
        const int bh = u >> 6, c = u & 63, b = bh >> 2, h = bh & 3; const size_t m0 = (size_t)b * SEQ + c * 64;
        const int t = tid >> 3, e0 = 16 * (tid & 7);
        bf16* gr = EV + (m0 + t) * EVW + EC_GR + h * 128 + e0;
        const bf16* oi = EV + (m0 + t) * EVW + EC_GK + h * 128 + e0; const v4u i0 = *(const v4u*)oi, i1 = *(const v4u*)(oi + 8);
        const v4u rr0 = *(const v4u*)gr, rr1 = *(const v4u*)(gr + 8);
        asm volatile("" ::: "memory"); __builtin_amdgcn_sched_barrier(0);
        {
#pragma unroll
          for (int nn = 0; nn < 4; ++nn) { const int nb = 4 * (wave & 1) + nn; f32x4 acc = zero4();
#pragma unroll
              for (int ks = 0; ks < 4; ++ks) acc = MFMA16(An[ks], Bn[nn][ks], acc);
#pragma unroll
              for (int i = 0; i < 4; ++i) ol[(16 * mb + 4 * g4 + i) * 132 + 16 * nb + l15] = acc[i]; } }
        { const int un = u + G < BATCH * 4 * 64 ? u + G : u; const int bhn = un >> 6, cn = un & 63, bn = bhn >> 2, hn = bhn & 3; const size_t m0n = (size_t)bn * SEQ + cn * 64; const bf16* stn = LT + (size_t)un * 128 * 128;
#pragma unroll
          for (int ks = 0; ks < 4; ++ks) An[ks] = *(const bf16x8*)(EV + (m0n + 16 * mb + l15) * EVW + EC_GQ + hn * 128 + 32 * ks + 8 * g4);
#pragma unroll
          for (int nn = 0; nn < 4; ++nn)
#pragma unroll
              for (int ks = 0; ks < 4; ++ks) Bn[nn][ks] = *(const bf16x8*)(stn + (((4 * (wave & 1) + nn) * 4 + ks) * 64 + lane) * 8); }
        __syncthreads();
        { float v[16], s = 0.f;
          { const float oiv[16] = {bflo(i0.x), bfhi(i0.x), bflo(i0.y), bfhi(i0.y), bflo(i0.z), bfhi(i0.z), bflo(i0.w), bfhi(i0.w), bflo(i1.x), bfhi(i1.x), bflo(i1.y), bfhi(i1.y), bflo(i1.z), bfhi(i1.z), bflo(i1.w), bfhi(i1.w)};
#pragma unroll
            for (int q4 = 0; q4 < 4; ++q4) { const f32x4 o4 = *(const LAS f32x4*)(ol + t * 132 + e0 + 4 * q4);
#pragma unroll
                for (int e = 0; e < 4; ++e) { v[4 * q4 + e] = o4[e] + oiv[4 * q4 + e]; s += v[4 * q4 + e]; } } }
          s += shx(s, 1, lane); s += shx(s, 2, lane); s += shx(s, 4, lane);
          const float mean = s * (1.f / 128.f); float s2 = 0.f;
#pragma unroll
          for (int e = 0; e < 16; ++e) { v[e] -= mean; s2 += v[e] * v[e]; }
          s2 += shx(s2, 1, lane); s2 += shx(s2, 2, lane); s2 += shx(s2, 4, lane);
          const float rstd = 1.f / sqrtf(s2 * (1.f / 128.f) + LN_EPS);
#pragma unroll
          for (int hf = 0; hf < 2; ++hf) { const v4u rr = hf ? rr1 : rr0; const float rv[8] = {bflo(rr.x), bfhi(rr.x), bflo(rr.y), bfhi(rr.y), bflo(rr.z), bfhi(rr.z), bflo(rr.w), bfhi(rr.w)}; float y[8];
#pragma unroll
              for (int e = 0; e < 8; ++e) { const float gg = gn[h * 128 + e0 + 8 * hf + e]; y[e] = v[8 * hf + e] * rstd * gg * (rv[e] * sigmoidf_(rv[e])); }
              v4u o; o.x = pk2(y[0], y[1]); o.y = pk2(y[2], y[3]); o.z = pk2(y[4], y[5]); o.w = pk2(y[6], y[7]); *(v4u*)(gr + 8 * hf) = o; } }
        __syncthreads();
    }
}

__device__ __forceinline__ void even_mixer(const Frame& F, int j, const XcdBarrier& bar) {
    e2_index_topk(F); STAMP(2);
    g1_gla_local(F, j);
    xcd_barrier(bar, F.wave); STAMP(3);
    e3_attention(F); STAMP(4);
    g2_gla_scan(F);
    xcd_barrier(bar, F.wave); STAMP(5);
    g3_gla_out(F, j);
    xcd_barrier(bar, F.wave); STAMP(6);
}
__global__ void __launch_bounds__(NWAVES * 64, 2) fwd(Args args) {
    Frame F;
    F.wave = __builtin_amdgcn_readfirstlane((int)threadIdx.x >> 6);
    F.G = gridDim.x; { const int bx = blockIdx.x; F.vcu = (F.G % 8 == 0) ? (bx % 8) * (F.G / 8) + bx / 8 : bx; }
    F.ap = (CArgs*)__builtin_amdgcn_kernarg_segment_ptr();
    { LAS unsigned* mz = (LAS unsigned*)(lds_base() + MISC_OFF); for (int u = threadIdx.x; u < (LDS_BYTES - MISC_OFF) / 4; u += NWAVES * 64) mz[u] = 0u; }
    __syncthreads();
    XcdBarrier bar = xcd_barrier_post((unsigned*)(as_global(F.ap->ws) + WS_CTL) + CW_BAR, (volatile LAS unsigned*)(lds_base() + MISC_OFF) + 8, F.wave);
#define GRID_BAR() xcd_barrier(bar, F.wave)
#define WSP(off) ((bf16*)(as_global(opq_p(F.ap)->ws) + (off)))

    if (PROBE_GA >= 0 || PROBE_DLY >= 0) { if (F.wave == 0 && lane_id() == 0) ((volatile LAS unsigned*)(lds_base() + MISC_OFF))[31] = (unsigned)__builtin_amdgcn_s_memrealtime(); }
    x_to_bf16(F);
    copy_ln_vectors(F);
    convert_layer(F, 0, 3);
    colsum_items(F, 0, 1);
    fold_small(F);
    GRID_BAR(); STAMP(1);
    static_assert(pg8::LNW_XB == WS_XB && pg8::LNW_PS0 == WS_PS0 && pg8::LNW_PS1 == WS_SMALL + SM_PS1 && pg8::LNW_COLV == WS_SMALL + SM_COLV && pg8::LN_ST_OFF == LDS_ST_OFF && pg8::LN_RED_OFF == LDS_RED_OFF && pg8::LN_COL_OFF == LDS_COL_OFF, "layout constants");
#define PSBUF(k) ((const pg8::f32x4*)(as_global(opq_p(F.ap)->ws) + ((k) ? WS_SMALL + SM_PS1 : WS_PS0)))
#define COLV(i) ((const float*)(as_global(opq_p(F.ap)->ws) + WS_SMALL + SM_COLV) + (i) * 4096)
#define LNP(idx, ll) (as_global(opq_p(F.ap)->in[idx]) + (size_t)(ll) * DM)

    for (int l = 0; l < DEPTH; ++l) {
        const int j = l >> 1;
        const pg8::LNFold Lin{as_global(opq_p(F.ap)->ws), 0, 0, l > 0 ? 1 : 0};
        if ((l & 1) == 0) {
            { pg8::Gemm g{WSP(WS_XB), WSP(WS_WIN), M, EVW, DM, DM}; pg8::StaticOrder S; S.init(M, EVW, opq_s(F.G), opq_s((int)blockIdx.x));
              pg8::EpiEvenIn E{WSP(WS_BIG), EVW, WSP(WS_BIG + EV_IKT_OFF), EC_IK, Lin};
              pg8::gemm_phase<pg8::EpiEvenIn, pg8::StaticOrder, true, true>(opq_l(lds_base()), g, S, E, opq_s(F.wave)); }
        } else {
            { pg8::Gemm g{WSP(WS_XB), WSP(WS_WIN), M, 4096, DM, DM}; pg8::StaticOrder S; S.init(M, 4096, opq_s(F.G), opq_s((int)blockIdx.x));
              pg8::EpiOddIn E{WSP(WS_BIG), (bf16*)as_global(opq_p(F.ap)->out), Lin};
              pg8::gemm_phase<pg8::EpiOddIn, pg8::StaticOrder, true, true>(opq_l(lds_base()), g, S, E, opq_s(F.wave)); }
        }
        GRID_BAR(); STAMP(0);
        if (l > 0) { convert_layer(F, l, 2); colsum_items(F, l, 1); }
        if (l + 1 < DEPTH) { convert_layer(F, l + 1, 1); colsum_items(F, l + 1, 0); }
        __syncthreads(); STAMP(1);
        if ((l & 1) == 0) {
            even_mixer(F, j, bar);
            { pg8::Gemm g{WSP(WS_BIG), WSP(WS_WOUT), M, DM, DM, EVW}; pg8::StaticOrder S; S.init(M, DM, opq_s(F.G), opq_s((int)blockIdx.x));
              pg8::EpiResidLN E{as_global(opq_p(F.ap)->ws), 0, 2 * 4 + (l > 0 ? l - 1 : 0), l > 0 ? 1 : 0, ALPHA};
              pg8::gemm_phase<pg8::EpiResidLN, pg8::StaticOrder, true, true>(opq_l(lds_base()), g, S, E, opq_s(F.wave)); }
        } else {
            odd_mixer(F, j, bar);
            { pg8::Gemm g{WSP(WS_BIG), WSP(WS_WOUT), M, DM, MI, MI}; pg8::StaticOrder S; S.init(M, DM, opq_s(F.G), opq_s((int)blockIdx.x));
              pg8::EpiResidLN E{as_global(opq_p(F.ap)->ws), 0, 2 * 4 + (l - 1), 1, ALPHA};
              pg8::gemm_phase<pg8::EpiResidLN, pg8::StaticOrder, true, true>(opq_l(lds_base()), g, S, E, opq_s(F.wave)); }
        }
        GRID_BAR(); STAMP(0);
        { pg8::Gemm g{WSP(WS_XB), WSP(WS_W1), M, FF, DM, DM}; pg8::StaticOrder S; S.init(M, FF, opq_s(F.G), opq_s((int)blockIdx.x));
          pg8::EpiBf16<1> E{WSP(WS_BIG), FF, pg8::LNFold{as_global(opq_p(F.ap)->ws), 1, 1, 1}};
          pg8::gemm_phase<pg8::EpiBf16<1>, pg8::StaticOrder, true, true>(opq_l(lds_base()), g, S, E, opq_s(F.wave)); }
        GRID_BAR(); STAMP(0);
        { pg8::Gemm g{WSP(WS_BIG), WSP(WS_W2), M, DM, FF, FF}; pg8::StaticOrder S; S.init(M, DM, opq_s(F.G), opq_s((int)blockIdx.x));
          pg8::EpiResidLN E{as_global(opq_p(F.ap)->ws), 1, 0 * 4 + l, 1, ALPHA};
          pg8::gemm_phase<pg8::EpiResidLN, pg8::StaticOrder, true, true>(opq_l(lds_base()), g, S, E, opq_s(F.wave)); }
        GRID_BAR(); STAMP(0);
    }
    ln_phase(F, I_LN2G, I_LN2B, DEPTH - 1, true);
}

extern "C" void kernel_launch(void* const* d_in, const int* in_sizes, int n_in, void* d_out, int out_size, void* d_ws, size_t ws_size, hipStream_t stream) {
    static int grid = 0;
    if (grid == 0) {
        if (n_in != 23 || in_sizes[0] != M * DM || out_size != M * DM || ws_size < WS_END) { fprintf(stderr, "kernel_launch: unexpected shapes / workspace (n_in %d, in0 %d, out %d, ws %zu); nothing launched\n", n_in, n_in > 0 ? in_sizes[0] : -1, out_size, ws_size); grid = -1; return; }
        int dev = 0, cus = 0, per_cu = 0;
        if (hipGetDevice(&dev) != hipSuccess || hipDeviceGetAttribute(&cus, hipDeviceAttributeMultiprocessorCount, dev) != hipSuccess) { grid = -1; return; }
        if (hipFuncSetAttribute((const void*)fwd, hipFuncAttributeMaxDynamicSharedMemorySize, LDS_BYTES) != hipSuccess) { fprintf(stderr, "kernel_launch: hipFuncSetAttribute failed\n"); grid = -1; return; }
        if (hipOccupancyMaxActiveBlocksPerMultiprocessor(&per_cu, (const void*)fwd, NWAVES * 64, LDS_BYTES) != hipSuccess || per_cu < 1) { fprintf(stderr, "kernel_launch: occupancy query reports %d\n", per_cu); }
        (void)hipGetLastError();
        grid = cus;
    }
    if (grid < 0) return;
    if (hipMemsetAsync((char*)d_ws + WS_CTL, 0, CTL_ZERO_BYTES, stream) != hipSuccess) return;
    Args a{};
    for (int i = 0; i < 23; ++i) a.in[i] = (const float*)d_in[i];
    a.out = (float*)d_out; a.ws = (unsigned char*)d_ws;
    hipLaunchKernelGGL(fwd, dim3(grid), dim3(NWAVES * 64), LDS_BYTES, stream, a);
}
```

```cpp
#include <hip/hip_runtime.h>
#include <cstdio>
#include <cstdint>
namespace pg8 {
#define PG8_LAS __attribute__((address_space(3)))
typedef unsigned short bf16_t;
typedef short bf16x8 __attribute__((ext_vector_type(8)));
typedef float f32x4 __attribute__((ext_vector_type(4)));
typedef unsigned u32x4 __attribute__((ext_vector_type(4)));
constexpr int BM = 256, BK = 64, HALF = 128, HTB = HALF * BK * 2  , STAGE_BYTES = 8 * HTB, NXCD = 8, WGM = 4;

__host__ __device__ __forceinline__ int lds_byte(int r, int c) { const int st = (r >> 4) * 2 + (c >> 5), rr = r & 15, cc = c & 31, ob = rr * 64 + cc * 2; return st * 1024 + (ob ^ (((ob >> 9) & 1) << 5)); }
__host__ __device__ __forceinline__ void stage_rc(int b, int& R, int& C) { const int st = b / 1024, sb = b % 1024, swz = sb ^ (((sb >> 9) & 1) << 5); R = (st >> 1) * 16 + swz / 64; C = (st & 1) * 32 + (swz % 64) / 2; }
__host__ __device__ __forceinline__ int perm32(int rho) { const int n = rho >> 4, i = rho & 15; return 8 * (i >> 2) + 4 * n + (i & 3); }

__device__ __forceinline__ int lane_id_v() { int x; asm volatile("v_mbcnt_lo_u32_b32 %0, -1, 0\n\tv_mbcnt_hi_u32_b32 %0, -1, %0" : "=v"(x)); return x; }
struct Unit { int pm, pn, idx; };
struct Gemm { const bf16_t* A; const bf16_t* Bt; int M, N, K, lda; };

struct StaticOrder {
    int nM, nN, nwg, G, c;
    __host__ __device__ void init(int M, int N, int G_, int c_) { nM = M / BM; nN = N / BM; nwg = nM * nN; G = G_; c = c_; }
    __host__ __device__ bool next(int i, Unit& u) const {
        const long L = (long)i * G + c; if (L >= nwg) return false;
        u.idx = i;
        int wgid = (int)L; { const int q = nwg / NXCD, r = nwg % NXCD, xcd = wgid % NXCD, off = wgid / NXCD; wgid = (xcd < r ? xcd * (q + 1) : r * (q + 1) + (xcd - r) * q) + off; }
        const int nig = WGM * nN, gid = wgid / nig, fm = gid * WGM, gsz = (nM - fm) < WGM ? (nM - fm) : WGM;
        u.pm = fm + ((wgid % nig) % gsz); u.pn = (wgid % nig) / gsz; return true;
    }
    __device__ __forceinline__ void a_ready(const Unit&) const {}
    __device__ __forceinline__ void done(const Unit&) const {}
};

typedef __bf16 pbf16x2_t __attribute__((ext_vector_type(2))); typedef float pf32x2_t __attribute__((ext_vector_type(2)));
__device__ __forceinline__ unsigned cvt_pk_bf16(float lo, float hi) { const pf32x2_t v = {lo, hi}; return __builtin_bit_cast(unsigned, __builtin_convertvector(v, pbf16x2_t)); }
__device__ __forceinline__ float bf_lo(unsigned w) { return __uint_as_float(w << 16); }
__device__ __forceinline__ float bf_hi(unsigned w) { return __uint_as_float(w & 0xffff0000u); }

constexpr size_t LNW_XB = (size_t)41 << 20, LNW_PS0 = (size_t)505 << 20, LNW_PS1 = ((size_t)29 << 20) + ((size_t)11 << 20), LNW_COLV = ((size_t)29 << 20) + ((size_t)8 << 20) + ((size_t)512 << 10), LNW_LNV = LNW_COLV + 65536;
constexpr int LN_ST_OFF = 131072, LN_RED_OFF = 147456, LN_COL_OFF = 155648;
__device__ __forceinline__ PG8_LAS float* ln_lds(int off) { extern __shared__ __attribute__((aligned(16))) unsigned char lds_raw[]; return (PG8_LAS float*)((PG8_LAS unsigned char*)lds_raw + off); }
__device__ __forceinline__ const f32x4* ln_ps(unsigned char* ws, int psel) { return (const f32x4*)(ws + (psel ? LNW_PS1 : LNW_PS0)); }
struct LNFold { unsigned char* ws; int psel, csel, on; };
__device__ __forceinline__ void ln_stage_cols(const float* v0, const float* v1, int pn, int idx, int wid, int lane) {
    if (wid < 2) { const float* src = (wid ? v1 : v0) + pn * BM + lane * 4;
        __builtin_amdgcn_global_load_lds((const unsigned*)src, (PG8_LAS unsigned*)(ln_lds(LN_COL_OFF) + ((idx & 1) * 2 + wid) * 256), 16, 0, 0); }
}
struct LNPrep { f32x4 p[8]; };
template <class Sched>
__device__ __forceinline__ void ln_prepare_issue(const f32x4* PS, int on, const Sched& S, int tid, LNPrep& P) {
    if (!on) return;
#pragma unroll
    for (int i = 0; i < 8; ++i) { Unit u; const bool ok = S.next(i, u); const int r = (ok ? u.pm : 0) * BM + (tid >> 1); P.p[i] = PS[(size_t)r * 2 + (tid & 1)]; }
}
__device__ __forceinline__ void ln_prepare_finish(int on, PG8_LAS float* st, int tid, const LNPrep& P) {
    if (!on) return;
#pragma unroll
    for (int i = 0; i < 8; ++i) { float S_ = P.p[i][0] + P.p[i][2], Q_ = P.p[i][1] + P.p[i][3];
        S_ += __builtin_bit_cast(float, __builtin_amdgcn_ds_bpermute(((tid & 63) ^ 1) << 2, __builtin_bit_cast(int, S_)));
        Q_ += __builtin_bit_cast(float, __builtin_amdgcn_ds_bpermute(((tid & 63) ^ 1) << 2, __builtin_bit_cast(int, Q_)));
        const float mu = S_ * (1.0f / 1024.0f), var = fmaxf(Q_ * (1.0f / 1024.0f) - mu * mu, 0.f), rs = __builtin_amdgcn_rsqf(var + 1e-5f);
        if ((tid & 1) == 0) { st[(i * BM + (tid >> 1)) * 2] = rs; st[(i * BM + (tid >> 1)) * 2 + 1] = -mu * rs; } }
}
typedef float pf32x2s_t __attribute__((ext_vector_type(2)));
__device__ __forceinline__ void ln_row(const PG8_LAS float* st, int on, int idx, int rl, float& rs, float& nmrs) {
    const pf32x2s_t v = *(const PG8_LAS pf32x2s_t*)(st + (idx * BM + rl) * 2);
    rs = on ? v[0] : 1.f; nmrs = on ? v[1] : 0.f;
}
struct LNCols { f32x4 c[2][2], b[2][2]; };
__device__ __forceinline__ void ln_cols(int on, int idx, int cl, LNCols& C) {
    const PG8_LAS float* cb = ln_lds(LN_COL_OFF) + (idx & 1) * 512 + cl; const f32x4 z = {0.f, 0.f, 0.f, 0.f};
#pragma unroll
    for (int bj = 0; bj < 2; ++bj)
#pragma unroll
        for (int h = 0; h < 2; ++h) { const f32x4 c = *(const PG8_LAS f32x4*)(cb + bj * HALF + 4 * h), b = *(const PG8_LAS f32x4*)(cb + 256 + bj * HALF + 4 * h);
            C.c[bj][h] = on ? c : z; C.b[bj][h] = on ? b : z; }
}
__device__ __forceinline__ void ln_fix(f32x4& v0, f32x4& v1, float rs, float nmrs, const LNCols& C, int bj) {
    const pf32x2_t rs2 = {rs, rs}, nm2 = {nmrs, nmrs};
#pragma unroll
    for (int j = 0; j < 4; j += 2) {
        const pf32x2_t a = {v0[j], v0[j + 1]}, c = {C.c[bj][0][j], C.c[bj][0][j + 1]}, b = {C.b[bj][0][j], C.b[bj][0][j + 1]}; const pf32x2_t r = __builtin_elementwise_fma(rs2, a, __builtin_elementwise_fma(nm2, c, b)); v0[j] = r[0]; v0[j + 1] = r[1];
        const pf32x2_t a1 = {v1[j], v1[j + 1]}, c1 = {C.c[bj][1][j], C.c[bj][1][j + 1]}, b1 = {C.b[bj][1][j], C.b[bj][1][j + 1]}; const pf32x2_t r1 = __builtin_elementwise_fma(rs2, a1, __builtin_elementwise_fma(nm2, c1, b1)); v1[j] = r1[0]; v1[j + 1] = r1[1]; }
}

template <int ACT> struct EpiBf16 {
    static constexpr bool PERM = true, AFTER_DRAIN = false;
    bf16_t* O; int ldc; LNFold L;
    template <class Sched> __device__ __forceinline__ void prepare_issue(const Sched& S, int tid, LNPrep& P) const { ln_prepare_issue(ln_ps(L.ws, L.psel), L.on, S, tid, P); }
    __device__ __forceinline__ void prepare_finish(int tid, const LNPrep& P) const { ln_prepare_finish(L.on, ln_lds(LN_ST_OFF), tid, P); }
    __device__ __forceinline__ void stage(const Unit& u, int wid, int lane) const { if (L.on) { const float* cs = (const float*)(L.ws + LNW_COLV) + L.csel * 8192; ln_stage_cols(cs, cs + 4096, u.pn, u.idx, wid, lane); } }
    __device__ __forceinline__ void operator()(const f32x4 (&acc)[2][2][4][2], const Unit& u, int wr, int wc, int fr_, int fq_) const {
        const int fr = fr_, fq = fq_;
        const int row0 = u.pm * BM + wr * 64 + fr, col0 = u.pn * BM + wc * 32 + 8 * fq;
        LNCols C; ln_cols(L.on, u.idx, wc * 32 + 8 * fq, C);
#pragma unroll
        for (int ai = 0; ai < 2; ++ai) {
#pragma unroll
            for (int m = 0; m < 4; ++m) { const int r = row0 + ai * HALF + m * 16; bf16_t* rowp = O + (size_t)r * ldc + col0;
                float rs, nmrs; ln_row(ln_lds(LN_ST_OFF), L.on, u.idx, ai * HALF + wr * 64 + m * 16 + fr, rs, nmrs);
#pragma unroll
                for (int bj = 0; bj < 2; ++bj) { f32x4 v0 = acc[ai][bj][m][0], v1 = acc[ai][bj][m][1];
                    ln_fix(v0, v1, rs, nmrs, C, bj);
                    if (ACT == 1) {
#pragma unroll
                        for (int j = 0; j < 4; ++j) { const float a = fmaxf(v0[j], 0.f), b = fmaxf(v1[j], 0.f); v0[j] = a * a; v1[j] = b * b; } }
                    u32x4 w; w.x = cvt_pk_bf16(v0[0], v0[1]); w.y = cvt_pk_bf16(v0[2], v0[3]); w.z = cvt_pk_bf16(v1[0], v1[1]); w.w = cvt_pk_bf16(v1[2], v1[3]);
                    *(u32x4*)(rowp + bj * HALF) = w; } } }
    }
};
struct EpiEvenIn {
    static constexpr bool PERM = true, AFTER_DRAIN = false;
    bf16_t* O; int ldc; bf16_t* IKt; int ik0; LNFold L;
    template <class Sched> __device__ __forceinline__ void prepare_issue(const Sched& S, int tid, LNPrep& P) const { ln_prepare_issue(ln_ps(L.ws, L.psel), L.on, S, tid, P); }
    __device__ __forceinline__ void prepare_finish(int tid, const LNPrep& P) const { ln_prepare_finish(L.on, ln_lds(LN_ST_OFF), tid, P); }
    __device__ __forceinline__ void stage(const Unit& u, int wid, int lane) const { if (L.on) { const float* cs = (const float*)(L.ws + LNW_COLV) + L.csel * 8192; ln_stage_cols(cs, cs + 4096, u.pn, u.idx, wid, lane); } }
    __device__ __forceinline__ void operator()(const f32x4 (&acc)[2][2][4][2], const Unit& u, int wr, int wc, int fr_, int fq_) const {
        const int fr = fr_, fq = fq_;
        const int row0 = u.pm * BM + wr * 64 + fr, col0 = u.pn * BM + wc * 32 + 8 * fq;
        LNCols C; ln_cols(L.on, u.idx, wc * 32 + 8 * fq, C);
#pragma unroll
        for (int ai = 0; ai < 2; ++ai) {
#pragma unroll
            for (int m = 0; m < 4; ++m) { const int r = row0 + ai * HALF + m * 16; bf16_t* rowp = O + (size_t)r * ldc + col0;
                float rs, nmrs; ln_row(ln_lds(LN_ST_OFF), L.on, u.idx, ai * HALF + wr * 64 + m * 16 + fr, rs, nmrs);
#pragma unroll
                for (int bj = 0; bj < 2; ++bj) { f32x4 v0 = acc[ai][bj][m][0], v1 = acc[ai][bj][m][1];
                    ln_fix(v0, v1, rs, nmrs, C, bj);
                    u32x4 w; w.x = cvt_pk_bf16(v0[0], v0[1]); w.y = cvt_pk_bf16(v0[2], v0[3]); w.z = cvt_pk_bf16(v1[0], v1[1]); w.w = cvt_pk_bf16(v1[2], v1[3]);
                    *(u32x4*)(rowp + bj * HALF) = w;
                    const int d0 = col0 + bj * HALF - ik0;
                    if (d0 >= 0 && d0 < 64) *(u32x4*)(IKt + ((size_t)((r >> 5) * 4 + (d0 >> 4)) * 64 + ((d0 >> 3) & 1) * 32 + (r & 31)) * 8) = w; } } }
    }
};
struct EpiOddIn {
    static constexpr bool PERM = true, AFTER_DRAIN = false;
    bf16_t* XM; bf16_t* OG; LNFold L;
    template <class Sched> __device__ __forceinline__ void prepare_issue(const Sched& S, int tid, LNPrep& P) const { ln_prepare_issue(ln_ps(L.ws, L.psel), L.on, S, tid, P); }
    __device__ __forceinline__ void prepare_finish(int tid, const LNPrep& P) const { ln_prepare_finish(L.on, ln_lds(LN_ST_OFF), tid, P); }
    __device__ __forceinline__ void stage(const Unit& u, int wid, int lane) const { if (L.on) { const float* cs = (const float*)(L.ws + LNW_COLV) + L.csel * 8192; ln_stage_cols(cs, cs + 4096, u.pn, u.idx, wid, lane); } }
    __device__ __forceinline__ void operator()(const f32x4 (&acc)[2][2][4][2], const Unit& u, int wr, int wc, int fr_, int fq_) const {
        const int fr = fr_, fq = fq_;
        const bool gate = u.pn >= 8;
        bf16_t* base = gate ? OG : XM;
        const int row0 = u.pm * BM + wr * 64 + fr, col0 = (u.pn & 7) * BM + wc * 32 + 8 * fq;
        LNCols C; ln_cols(L.on, u.idx, wc * 32 + 8 * fq, C);
#pragma unroll
        for (int ai = 0; ai < 2; ++ai) {
#pragma unroll
            for (int m = 0; m < 4; ++m) { const int r = row0 + ai * HALF + m * 16; bf16_t* rowp = base + (size_t)r * 2048 + col0;
                float rs, nmrs; ln_row(ln_lds(LN_ST_OFF), L.on, u.idx, ai * HALF + wr * 64 + m * 16 + fr, rs, nmrs);
#pragma unroll
                for (int bj = 0; bj < 2; ++bj) { f32x4 v0 = acc[ai][bj][m][0], v1 = acc[ai][bj][m][1];
                    ln_fix(v0, v1, rs, nmrs, C, bj);
                    if (gate) {
#pragma unroll
                        for (int j = 0; j < 4; ++j) { v0[j] = __builtin_amdgcn_rcpf(1.0f + __expf(-v0[j])); v1[j] = __builtin_amdgcn_rcpf(1.0f + __expf(-v1[j])); } }
                    u32x4 w; w.x = cvt_pk_bf16(v0[0], v0[1]); w.y = cvt_pk_bf16(v0[2], v0[3]); w.z = cvt_pk_bf16(v1[0], v1[1]); w.w = cvt_pk_bf16(v1[2], v1[3]);
                    *(u32x4*)(rowp + bj * HALF) = w; } } }
    }
};
struct EpiResidLN {
    static constexpr bool PERM = true, AFTER_DRAIN = false;
    unsigned char* ws; int psel, gsel, on; float alpha;
    template <class Sched> __device__ __forceinline__ void prepare_issue(const Sched& S, int tid, LNPrep& P) const { ln_prepare_issue(ln_ps(ws, psel), on, S, tid, P); }
    __device__ __forceinline__ void prepare_finish(int tid, const LNPrep& P) const { ln_prepare_finish(on, ln_lds(LN_ST_OFF), tid, P); }
    __device__ __forceinline__ void stage(const Unit& u, int wid, int lane) const { if (on) { const float* g = (const float*)(ws + LNW_LNV) + gsel * 1024; ln_stage_cols(g, g + 4 * 1024, u.pn, u.idx, wid, lane); } }
    __device__ __forceinline__ void operator()(const f32x4 (&acc)[2][2][4][2], const Unit& u, int wr, int wc, int fr_, int fq_) const {
        const int fr = fr_, fq = fq_;
        const int row0 = u.pm * BM + wr * 64 + fr, col0 = u.pn * BM + wc * 32 + 8 * fq, lane = fq * 16 + fr;
        bf16_t* T = (bf16_t*)(ws + LNW_XB); float* PSout = (float*)(ws + (psel ? LNW_PS0 : LNW_PS1));
        PG8_LAS float* st = ln_lds(LN_ST_OFF); PG8_LAS float* red = ln_lds(LN_RED_OFF);
        f32x4 ag[2][2], ab[2][2];
#pragma unroll
        for (int bj = 0; bj < 2; ++bj)
#pragma unroll
            for (int h = 0; h < 2; ++h) {
                const PG8_LAS float* cb = ln_lds(LN_COL_OFF) + (u.idx & 1) * 512 + wc * 32 + 8 * fq + bj * HALF + 4 * h; const f32x4 gq = *(const PG8_LAS f32x4*)cb, bq = *(const PG8_LAS f32x4*)(cb + 256);
                ag[bj][h] = on ? gq * alpha : (f32x4){alpha, alpha, alpha, alpha}; ab[bj][h] = on ? bq * alpha : (f32x4){0.f, 0.f, 0.f, 0.f}; }
#pragma unroll
        for (int ai = 0; ai < 2; ++ai) {
            float sq[4][2];
            u32x4 xb[4][2];
#pragma unroll
            for (int m = 0; m < 4; ++m)
#pragma unroll
                for (int bj = 0; bj < 2; ++bj) xb[m][bj] = *(const u32x4*)(T + (size_t)(row0 + ai * HALF + m * 16) * 1024 + col0 + bj * HALF);
            asm volatile("" ::: "memory");
#pragma unroll
            for (int m = 0; m < 4; ++m) { const int r = row0 + ai * HALF + m * 16; const size_t off = (size_t)r * 1024 + col0;
                float rs, nmrs; ln_row(st, on, u.idx, ai * HALF + wr * 64 + m * 16 + fr, rs, nmrs);
                const pf32x2_t rs2 = {rs, rs}, nm2 = {nmrs, nmrs}; pf32x2_t s2 = {0.f, 0.f}, q2 = {0.f, 0.f};
#pragma unroll
                for (int bj = 0; bj < 2; ++bj) { const size_t o2 = off + bj * HALF; const u32x4 x = xb[m][bj];
                    const unsigned xw[4] = {x.x, x.y, x.z, x.w}; unsigned ww[4];
#pragma unroll
                    for (int p = 0; p < 4; ++p) { const int h = p >> 1, j = (p & 1) * 2;
                        const pf32x2_t t = {bf_lo(xw[p]), bf_hi(xw[p])}, g2 = {ag[bj][h][j], ag[bj][h][j + 1]}, b2 = {ab[bj][h][j], ab[bj][h][j + 1]}, a2 = {acc[ai][bj][m][h][j], acc[ai][bj][m][h][j + 1]};
                        const pf32x2_t v = __builtin_elementwise_fma(t, rs2 * g2, __builtin_elementwise_fma(nm2, g2, b2)) + a2;
                        ww[p] = cvt_pk_bf16(v[0], v[1]);
                        const pf32x2_t e = {bf_lo(ww[p]), bf_hi(ww[p])};
                        s2 += e; q2 = __builtin_elementwise_fma(e, e, q2); }
                    u32x4 w; w.x = ww[0]; w.y = ww[1]; w.z = ww[2]; w.w = ww[3];
                    *(u32x4*)(T + o2) = w; }
                sq[m][0] = s2[0] + s2[1]; sq[m][1] = q2[0] + q2[1]; }
#pragma unroll
            for (int m = 0; m < 4; ++m)
#pragma unroll
                for (int k = 0; k < 2; ++k) sq[m][k] += __builtin_bit_cast(float, __builtin_amdgcn_ds_bpermute((lane ^ 16) << 2, __builtin_bit_cast(int, sq[m][k])));
#pragma unroll
            for (int m = 0; m < 4; ++m)
#pragma unroll
                for (int k = 0; k < 2; ++k) sq[m][k] += __builtin_bit_cast(float, __builtin_amdgcn_ds_bpermute((lane ^ 32) << 2, __builtin_bit_cast(int, sq[m][k])));
            if (fq == 0) {
#pragma unroll
                for (int m = 0; m < 4; ++m) { const int rl = ai * HALF + wr * 64 + m * 16 + fr; red[(rl * 4 + wc) * 2] = sq[m][0]; red[(rl * 4 + wc) * 2 + 1] = sq[m][1]; } } }
        asm volatile("s_waitcnt lgkmcnt(0)" ::: "memory"); __builtin_amdgcn_s_barrier();
        { const int tid = (wr * 4 + wc) * 64 + lane;
          if (tid < BM) { const f32x4 p01 = *(const PG8_LAS f32x4*)(red + tid * 8), p23 = *(const PG8_LAS f32x4*)(red + tid * 8 + 4);
              float* o = PSout + ((size_t)(u.pm * BM + tid) * 4 + u.pn) * 2;
              o[0] = (p01[0] + p01[2]) + (p23[0] + p23[2]); o[1] = (p01[1] + p01[3]) + (p23[1] + p23[3]); } }
    }
};

template <class Epi, class Sched, bool ALIGN_EPI = false, bool SP2 = false>
__device__ __forceinline__ void gemm_phase(PG8_LAS unsigned char* lds, const Gemm g, const Sched& S, const Epi& E, int wid_in) {
    const int wid = wid_in, lane = lane_id_v(), tid = wid * 64 + lane, wr = wid >> 2, wc = wid & 3, fr = lane & 15, fq = lane >> 4;
    const int K = g.K, nt = K / BK;
    unsigned voffA[2], voffB[2];
#pragma unroll
    for (int i = 0; i < 2; ++i) { int R, C; stage_rc(tid * 16 + i * 8192, R, C); const int Rb = Epi::PERM ? ((R & ~31) + perm32(R & 31)) : R;
        voffA[i] = (unsigned)(R * g.lda + C) * 2u; voffB[i] = (unsigned)(Rb * K + C) * 2u; }
    const size_t kstep = (size_t)(BK * 2);
    const size_t hstep = (size_t)HALF * K * 2;
    const size_t tstep = 2 * hstep;
    const size_t hstepA = (size_t)HALF * g.lda * 2, tstepA = 2 * hstepA;
    const unsigned ldsw = (unsigned)wid * 1024u;
    const int aoff = lds_byte(wr * 64 + fr, fq * 8), boff = lds_byte(wc * 32 + fr, fq * 8);
#define PG8_SA(b, h) (((b) * 2 + (h)) * HTB)
#define PG8_SB(b, h) ((4 + (b) * 2 + (h)) * HTB)
#define PG8_STAGE(bufoff, gbase, voff) do { _Pragma("unroll") for (int _i = 0; _i < 2; ++_i) \
        __builtin_amdgcn_global_load_lds((const unsigned*)((const char*)(gbase) + (voff)[_i]), (PG8_LAS unsigned*)(lds + (bufoff) + ldsw + _i * 8192), 16, 0, 0); } while (0)
#define PG8_LDA(dst, b, h) do { _Pragma("unroll") for (int m = 0; m < 4; ++m) _Pragma("unroll") for (int k = 0; k < 2; ++k) dst[m][k] = *(const PG8_LAS bf16x8*)(lds + PG8_SA(b, h) + aoff + m * 2048 + k * 1024); } while (0)
#define PG8_LDB(dst, b, h) do { _Pragma("unroll") for (int n = 0; n < 2; ++n) _Pragma("unroll") for (int k = 0; k < 2; ++k) dst[n][k] = *(const PG8_LAS bf16x8*)(lds + PG8_SB(b, h) + boff + n * 2048 + k * 1024); } while (0)
#define PG8_MMA(ai, bj, At, Bt) do { __builtin_amdgcn_s_setprio(1); _Pragma("unroll") for (int m = 0; m < 4; ++m) _Pragma("unroll") for (int n = 0; n < 2; ++n) _Pragma("unroll") for (int k = 0; k < 2; ++k) \
        acc[ai][bj][m][n] = __builtin_amdgcn_mfma_f32_16x16x32_bf16(Bt[n][k], At[m][k], acc[ai][bj][m][n], 0, 0, 0); __builtin_amdgcn_s_setprio(0); } while (0)
#define PG8_WAIT_V(n) asm volatile("s_waitcnt vmcnt(" #n ")" ::: "memory")
#define PG8_WAIT_L(n) asm volatile("s_waitcnt lgkmcnt(" #n ")" ::: "memory")
#define PG8_BAR __builtin_amdgcn_s_barrier()
#define PG8_SCHED __builtin_amdgcn_sched_barrier(0)
    Unit cur, nxt; int ui = 0;
    LNPrep lnprep; E.prepare_issue(S, tid, lnprep);
    if (!S.next(0, cur)) return;
    f32x4 acc[2][2][4][2];
#pragma unroll
    for (int a = 0; a < 2; ++a)
#pragma unroll
        for (int b = 0; b < 2; ++b)
#pragma unroll
            for (int m = 0; m < 4; ++m)
#pragma unroll
                for (int n = 0; n < 2; ++n) acc[a][b][m][n] = (f32x4){0.f, 0.f, 0.f, 0.f};
    bf16x8 At[4][2], B0[2][2], B1[2][2];
    const char* cA = (const char*)g.A + (size_t)cur.pm * tstepA; const char* cB = (const char*)g.Bt + (size_t)cur.pn * tstep;
    S.a_ready(cur);
    E.stage(cur, wid, lane_id_v());
    if constexpr (SP2) {
        PG8_STAGE(PG8_SB(0, 0), cB, voffB); PG8_STAGE(PG8_SB(0, 1), cB + hstep, voffB); PG8_STAGE(PG8_SA(0, 0), cA, voffA); PG8_STAGE(PG8_SA(0, 1), cA + hstepA, voffA);
        if (wr == 1) PG8_BAR;
        PG8_WAIT_V(2); PG8_BAR;
        PG8_STAGE(PG8_SB(1, 0), cB + kstep, voffB); PG8_STAGE(PG8_SA(1, 0), cA + kstep, voffA); PG8_STAGE(PG8_SB(1, 1), cB + hstep + kstep, voffB);
        PG8_WAIT_V(6); PG8_BAR;
    } else {
        PG8_STAGE(PG8_SB(0, 0), cB, voffB); PG8_STAGE(PG8_SA(0, 0), cA, voffA); PG8_STAGE(PG8_SB(0, 1), cB + hstep, voffB); PG8_STAGE(PG8_SA(0, 1), cA + hstepA, voffA);
        if (wr == 1) PG8_BAR;
        PG8_WAIT_V(4); PG8_BAR;
        PG8_STAGE(PG8_SB(1, 0), cB + kstep, voffB); PG8_STAGE(PG8_SA(1, 0), cA + kstep, voffA); PG8_STAGE(PG8_SB(1, 1), cB + hstep + kstep, voffB);
        PG8_WAIT_V(6); PG8_BAR;
    }
    E.prepare_finish(tid, lnprep);
    for (;;) {
        const bool has_next = S.next(ui + 1, nxt);
        const char* nA = has_next ? (const char*)g.A + (size_t)nxt.pm * tstepA : cA; const char* nB = has_next ? (const char*)g.Bt + (size_t)nxt.pn * tstep : cB;
        for (int t = 0; t < nt; t += 2) {
            const bool last = (t == nt - 2);
            const char* a1 = cA + (size_t)(t + 1) * kstep;
            const char* a2 = last ? nA : cA + (size_t)(t + 2) * kstep; const char* b2 = last ? nB : cB + (size_t)(t + 2) * kstep;
            const char* a3 = a2 + kstep; const char* b3 = b2 + kstep;
            if (last && has_next) S.a_ready(nxt);
            if constexpr (SP2) {
            PG8_LDB(B0, 0, 0); PG8_LDB(B1, 0, 1); PG8_SCHED; PG8_LDA(At, 0, 0); PG8_STAGE(PG8_SA(1, 1), a1 + hstepA, voffA);
            PG8_WAIT_V(8); PG8_WAIT_L(0); PG8_BAR; PG8_MMA(0, 0, At, B0); PG8_MMA(0, 1, At, B1); PG8_BAR; PG8_SCHED;
            PG8_LDA(At, 0, 1); PG8_STAGE(PG8_SB(0, 0), b2, voffB); PG8_STAGE(PG8_SB(0, 1), b2 + hstep, voffB); PG8_STAGE(PG8_SA(0, 0), a2, voffA);
            PG8_WAIT_V(8); PG8_WAIT_L(0); PG8_BAR; PG8_MMA(1, 0, At, B0); PG8_MMA(1, 1, At, B1); PG8_BAR; PG8_SCHED;
            PG8_LDB(B0, 1, 0); PG8_LDB(B1, 1, 1); PG8_SCHED; PG8_LDA(At, 1, 0); PG8_STAGE(PG8_SA(0, 1), a2 + hstepA, voffA);
            PG8_WAIT_V(8); PG8_WAIT_L(0); PG8_BAR; PG8_MMA(0, 0, At, B0); PG8_MMA(0, 1, At, B1); PG8_BAR; PG8_SCHED;
            PG8_LDA(At, 1, 1); PG8_STAGE(PG8_SB(1, 0), b3, voffB); PG8_STAGE(PG8_SB(1, 1), b3 + hstep, voffB); PG8_STAGE(PG8_SA(1, 0), a3, voffA);
            PG8_WAIT_V(8); PG8_WAIT_L(0); PG8_BAR; PG8_MMA(1, 0, At, B0); PG8_MMA(1, 1, At, B1); PG8_BAR; PG8_SCHED;
            } else {
            PG8_LDB(B0, 0, 0); PG8_SCHED; PG8_LDA(At, 0, 0); PG8_STAGE(PG8_SA(1, 1), a1 + hstepA, voffA);
            PG8_WAIT_L(8); PG8_BAR; PG8_WAIT_L(0); PG8_MMA(0, 0, At, B0); PG8_BAR; PG8_SCHED;
            PG8_LDB(B1, 0, 1); PG8_STAGE(PG8_SB(0, 0), b2, voffB);
            PG8_BAR; PG8_WAIT_L(0); PG8_MMA(0, 1, At, B1); PG8_BAR;
            PG8_LDA(At, 0, 1); PG8_STAGE(PG8_SA(0, 0), a2, voffA);
            PG8_BAR; PG8_WAIT_L(0); PG8_MMA(1, 0, At, B0); PG8_BAR; PG8_SCHED;
            PG8_STAGE(PG8_SB(0, 1), b2 + hstep, voffB);
            PG8_WAIT_V(6); PG8_BAR; PG8_MMA(1, 1, At, B1); PG8_BAR;
            PG8_LDB(B0, 1, 0); PG8_SCHED; PG8_LDA(At, 1, 0); PG8_STAGE(PG8_SA(0, 1), a2 + hstepA, voffA);
            PG8_WAIT_L(8); PG8_BAR; PG8_WAIT_L(0); PG8_MMA(0, 0, At, B0); PG8_BAR; PG8_SCHED;
            PG8_LDB(B1, 1, 1); PG8_STAGE(PG8_SB(1, 0), b3, voffB);
            PG8_BAR; PG8_WAIT_L(0); PG8_MMA(0, 1, At, B1); PG8_BAR;
            PG8_LDA(At, 1, 1); PG8_STAGE(PG8_SA(1, 0), a3, voffA);
            PG8_BAR; PG8_WAIT_L(0); PG8_MMA(1, 0, At, B0); PG8_BAR; PG8_SCHED;
            PG8_STAGE(PG8_SB(1, 1), b3 + hstep, voffB);
            PG8_WAIT_V(6); PG8_BAR; PG8_MMA(1, 1, At, B1); PG8_BAR;
            }
        }
        if (has_next) E.stage(nxt, wid, lane_id_v());
        if constexpr (ALIGN_EPI) { if (wr == 0) PG8_BAR; }
        if constexpr (!Epi::AFTER_DRAIN) { const int l2 = lane_id_v(); E(acc, cur, wr, wc, l2 & 15, l2 >> 4); S.done(cur); }
        if (!has_next) break;
#pragma unroll
        for (int a = 0; a < 2; ++a)
#pragma unroll
            for (int b = 0; b < 2; ++b)
#pragma unroll
                for (int m = 0; m < 4; ++m)
#pragma unroll
                    for (int n = 0; n < 2; ++n) acc[a][b][m][n] = (f32x4){0.f, 0.f, 0.f, 0.f};
        cur = nxt; cA = nA; cB = nB; ++ui;
        if constexpr (ALIGN_EPI) { if (wr == 1) PG8_BAR; }
    }
    PG8_WAIT_V(0);
    if constexpr (!ALIGN_EPI) { if (wr == 0) PG8_BAR; }
    PG8_BAR;
    if constexpr (Epi::AFTER_DRAIN) { E.fused(acc, cur, wr, wc, fr, fq, lds, wid, lane); S.done(cur); }
#undef PG8_SA
#undef PG8_SB
#undef PG8_STAGE
#undef PG8_LDA
#undef PG8_LDB
#undef PG8_MMA
#undef PG8_WAIT_V
#undef PG8_WAIT_L
#undef PG8_BAR
#undef PG8_SCHED
}
}
constexpr int BATCH = 8, SEQ = 4096, DM = 1024, DEPTH = 4, FF = 4096;
constexpr int M = BATCH * SEQ;
constexpr float ALPHA = 1.6817928305074290f;
constexpr float LN_EPS = 1e-5f;
constexpr int NWAVES = 8;
constexpr int EVW = 3328;
constexpr int EC_AQ = 0, EC_GR = 512, EC_GQ = 1024, EC_GK = 1536, EC_GV = 2048, EC_IQ = 2560, EC_AK = 3072, EC_AV = 3136, EC_IK = 3200, EC_IW = 3264, EC_GLR = 3296;
constexpr int EV_SRCW = 3288;
constexpr size_t EV_IKT_OFF = (size_t)280 << 20;
constexpr int MI = 2048, MH = 4, MDH = 512, MCH = 64, NCH = SEQ / MCH;

constexpr size_t MiB = 1u << 20;
constexpr size_t WS_CTL = 0, CTL_ZERO_BYTES = 1 * MiB;
constexpr size_t WS_WIN = 1 * MiB, WS_WOUT = 9 * MiB, WS_W1 = 13 * MiB, WS_W2 = 21 * MiB;
constexpr size_t WS_SMALL = 29 * MiB;
constexpr size_t WS_XB = 41 * MiB;
constexpr size_t WS_AUX = 105 * MiB;
constexpr size_t WS_BIG = 121 * MiB;
constexpr size_t WS_PS0 = 505 * MiB;
constexpr size_t WS_END = 506 * MiB;
constexpr size_t SM_GATEW = 0;
constexpr size_t SM_KFOLD = 512 * 1024;
constexpr size_t SM_LI = 1 * MiB;
constexpr size_t SM_BC = 2 * MiB;
constexpr size_t SM_CHG = 3 * MiB;
constexpr size_t SM_WIN = 4 * MiB;
constexpr size_t SM_DEN = 5 * MiB;
constexpr size_t SM_EMM = 6 * MiB;
constexpr size_t SM_WK = 7 * MiB;
constexpr size_t SM_DEC = 8 * MiB;
constexpr size_t SM_GWT = 10 * MiB;
constexpr size_t SM_COLV = 8 * MiB + 512 * 1024;
constexpr size_t SM_PS1 = 11 * MiB;
constexpr int CW_BAR = 4096;

constexpr int RING_BYTES = 131072;
constexpr int LDSX_OFF = RING_BYTES;
constexpr int LDS_ST_OFF = RING_BYTES, LDS_RED_OFF = LDS_ST_OFF + 16384;
constexpr int LDS_COL_OFF = LDS_RED_OFF + 8192;
constexpr int MISC_OFF = 159744;
constexpr int LDS_BYTES = 161792;

#define GAS __attribute__((address_space(1)))
#define LAS __attribute__((address_space(3)))
typedef unsigned short bf16;
typedef unsigned v4u __attribute__((ext_vector_type(4)));
typedef unsigned v2u __attribute__((ext_vector_type(2)));
typedef float f32x4 __attribute__((ext_vector_type(4)));
typedef float f32x16 __attribute__((ext_vector_type(16)));
typedef short bf16x8 __attribute__((ext_vector_type(8)));
typedef short s16x4 __attribute__((ext_vector_type(4)));
typedef GAS unsigned gu32;
#define RLX_AGENT __ATOMIC_RELAXED, __HIP_MEMORY_SCOPE_AGENT
#define LDS_WAIT() asm volatile("s_waitcnt lgkmcnt(0)" ::: "memory")
#define VM_WAIT() asm volatile("s_waitcnt vmcnt(0)" ::: "memory")
typedef __bf16 bf16x2_t __attribute__((ext_vector_type(2)));
typedef float f32x2_t __attribute__((ext_vector_type(2)));
__device__ __forceinline__ unsigned pk2(float lo, float hi) { const f32x2_t v = {lo, hi}; return __builtin_bit_cast(unsigned, __builtin_convertvector(v, bf16x2_t)); }
__device__ __forceinline__ unsigned f2bf(float f) { return pk2(f, f) & 0xffffu; }
__device__ __forceinline__ float bf2f(unsigned short b) { return __uint_as_float(((unsigned)b) << 16); }
__device__ __forceinline__ float bflo(unsigned w) { return __uint_as_float(w << 16); }
__device__ __forceinline__ float bfhi(unsigned w) { return __uint_as_float(w & 0xffff0000u); }
__device__ __forceinline__ float shx(float v, int o, int lane) { return __builtin_bit_cast(float, __builtin_amdgcn_ds_bpermute((lane ^ o) << 2, __builtin_bit_cast(int, v))); }
__device__ __forceinline__ float shi(float v, int src) { return __builtin_bit_cast(float, __builtin_amdgcn_ds_bpermute(src << 2, __builtin_bit_cast(int, v))); }
__device__ __forceinline__ float wave_sum(float v, int lane) {
#pragma unroll
    for (int o = 1; o < 64; o <<= 1) v += shx(v, o, lane);
    return v;
}
__device__ __forceinline__ float sigmoidf_(float x) { return __builtin_amdgcn_rcpf(1.0f + __expf(-x)); }
__device__ __forceinline__ float logsigmoidf_(float x) { return fminf(x, 0.f) - __logf(1.0f + __expf(-fabsf(x))); }
#define MFMA16(a, b, c) __builtin_amdgcn_mfma_f32_16x16x32_bf16((a), (b), (c), 0, 0, 0)
#define MFMA32(a, b, c) __builtin_amdgcn_mfma_f32_32x32x16_bf16((a), (b), (c), 0, 0, 0)
__device__ __forceinline__ int lane_id() { int x; asm volatile("v_mbcnt_lo_u32_b32 %0, -1, 0\n\tv_mbcnt_hi_u32_b32 %0, -1, %0" : "=v"(x)); return x; }
__device__ __forceinline__ f32x4 zero4() { float z; asm volatile("v_mov_b32 %0, 0" : "=v"(z)); return (f32x4){z, z, z, z}; }
template <class T> __device__ __forceinline__ T* as_global(T* p) { GAS T* g = (GAS T*)p; asm volatile("" : "+s"(g)); return (T*)g; }
#define XB_TMO      128
#define XB_XCNT(j)  (256  + 64 * (j))
#define XB_XSUB(j)  (1280 + 64 * (j))
#define XB_XGEN(j)  (2304 + 64 * (j))
#define XB_TOP      3328
#define XB_TOPGEN   3392
#define XCD_BAR_WORDS 3456
#define XB_SPIN_CAP (1u << 18)

__device__ __forceinline__ unsigned xb_ld(unsigned* p)              { return __hip_atomic_load(p, __ATOMIC_RELAXED, __HIP_MEMORY_SCOPE_AGENT); }
__device__ __forceinline__ unsigned xb_add(unsigned* p, unsigned v) { return __hip_atomic_fetch_add(p, v, __ATOMIC_RELAXED, __HIP_MEMORY_SCOPE_AGENT); }
__device__ __forceinline__ unsigned xb_xcc_id() { return (unsigned)__builtin_amdgcn_s_getreg((3 << 11) | 20) & 0xFu; }
#define XB_SPIN(cond, bar) do { unsigned _sp = 0; while (cond) { __builtin_amdgcn_s_sleep(1); \
    if ((++_sp & 255u) == 0u) { if (xb_ld(&(bar)[XB_TMO])) break; if (_sp > XB_SPIN_CAP) { atomicAdd(&(bar)[XB_TMO], 1u); break; } } } } while (0)

struct XcdBarrier {
    unsigned* bar; unsigned x;
    volatile LAS unsigned* st;
};

__device__ __forceinline__ XcdBarrier xcd_barrier_post(unsigned* bar, volatile LAS unsigned* st, int wave) {
    XcdBarrier b; b.bar = bar; b.x = xb_xcc_id(); b.st = st;
    if (wave == 0 && lane_id() == 0) (void)xb_add(&bar[XB_XCNT(b.x)], 1u);
    return b;
}
__device__ __forceinline__ void xcd_barrier_complete(unsigned* bar, unsigned x, unsigned& nloc, unsigned& nx) {
    const unsigned G = gridDim.x * gridDim.y * gridDim.z;
    unsigned sum, cnt, mine, sp = 0u;
    for (;;) {
        sum = 0u; cnt = 0u; mine = 0u;
#pragma unroll
        for (unsigned j = 0; j < 16; ++j) { const unsigned c = xb_ld(&bar[XB_XCNT(j)]); sum += c; cnt += (c > 0u) ? 1u : 0u; mine = (j == x) ? c : mine; }
        if (sum == G) break;
        __builtin_amdgcn_s_sleep(1);
        if ((++sp & 255u) == 0u) { if (xb_ld(&bar[XB_TMO])) break; if (sp > XB_SPIN_CAP) { atomicAdd(&bar[XB_TMO], 1u); break; } }
    }
    nloc = mine > 0u ? mine : 1u; nx = cnt > 0u ? cnt : 1u;
}

__device__ __forceinline__ void xcd_barrier(const XcdBarrier& b, int wave) {
    asm volatile("s_waitcnt vmcnt(0)" ::: "memory");
    __syncthreads();
    if (wave == 0 && lane_id() == 0) {
        unsigned* bar = b.bar; asm volatile("" : "+s"(bar));
        __builtin_amdgcn_s_waitcnt(0);
        unsigned nloc = b.st[0], nx = b.st[1];
        if (nloc == 0u) { xcd_barrier_complete(bar, b.x, nloc, nx); b.st[0] = nloc; b.st[1] = nx; }
        const unsigned old = xb_add(&bar[XB_XSUB(b.x)], 1u);
        const unsigned gen = old / nloc;
        if (old + 1u == (gen + 1u) * nloc) {
            __builtin_amdgcn_fence(__ATOMIC_RELEASE, "agent");
            asm volatile("s_waitcnt vmcnt(0)" ::: "memory");
            const unsigned og = xb_add(&bar[XB_TOP], 1u);
            const unsigned tg = og / nx;
            if (og + 1u == (tg + 1u) * nx) xb_add(&bar[XB_TOPGEN], 1u);
            else XB_SPIN(xb_ld(&bar[XB_TOPGEN]) == tg, bar);
            __builtin_amdgcn_fence(__ATOMIC_ACQUIRE, "agent");
            xb_add(&bar[XB_XGEN(b.x)], 1u);
            asm volatile("s_waitcnt vmcnt(0)" ::: "memory");
        } else {
            XB_SPIN(xb_ld(&bar[XB_XGEN(b.x)]) == gen, bar);
            __builtin_amdgcn_fence(__ATOMIC_ACQUIRE, "agent");
            asm volatile("s_waitcnt vmcnt(0)" ::: "memory");
        }
    }
    __syncthreads();
}

struct Args { const float* in[23]; float* out; unsigned char* ws; };
typedef const __attribute__((address_space(4))) Args CArgs;
enum { I_X = 0, I_EV_WIN, I_EV_GW2, I_EV_GB2, I_EV_GNORM, I_EV_WOUT, I_OD_WIN, I_OD_CONVW, I_OD_CONVB, I_OD_WQ, I_OD_WK, I_OD_WV, I_OD_WGATE, I_OD_BGATE,
       I_OD_SKIP, I_OD_NORM, I_OD_WOUT, I_LN1G, I_LN1B, I_LN2G, I_LN2B, I_W1, I_W2 };
struct Frame { int wave, vcu, G; CArgs* ap; };
#ifndef PROBE_GA
#define PROBE_GA (-1)
#define PROBE_GB (-1)
#endif
#ifndef PROBE_DLY
#define PROBE_DLY (-1)
#endif
#define STAMP(grp) do { if (PROBE_GA >= 0 || PROBE_DLY >= 0) { if (F.wave == 0 && lane_id() == 0) { volatile LAS unsigned* mz_ = (volatile LAS unsigned*)(lds_base() + MISC_OFF); const unsigned t_ = (unsigned)__builtin_amdgcn_s_memrealtime(); const unsigned el_ = t_ - mz_[31]; mz_[32 + (grp)] += el_; \
    if (PROBE_DLY == (grp)) { while ((unsigned)__builtin_amdgcn_s_memrealtime() - t_ < el_) __builtin_amdgcn_s_sleep(8); } mz_[31] = (unsigned)__builtin_amdgcn_s_memrealtime(); } } } while (0)
__device__ __forceinline__ int opq_v(int x) { asm volatile("" : "+v"(x)); return x; }
__device__ __forceinline__ int opq_s(int x) { asm volatile("" : "+s"(x)); return x; }
__device__ __forceinline__ LAS unsigned char* lds_base() { extern __shared__ __attribute__((aligned(16))) unsigned char lds_raw[]; return (LAS unsigned char*)lds_raw; }
__device__ __forceinline__ CArgs* opq_p(CArgs* p) { asm volatile("" : "+s"(p)); return p; }
__device__ __forceinline__ LAS unsigned char* opq_l(LAS unsigned char* p) { asm volatile("" : "+s"(p)); return p; }
#define PHASE_UNIFORMS() const int wave = opq_s(F.wave), vcu = opq_s(F.vcu), G = opq_s(F.G), bid = opq_s((int)blockIdx.x); (void)wave; (void)vcu; (void)G; (void)bid

__device__ __forceinline__ void transpose_item(const float* W, int K, int Ns, bf16* WT, int k0, int n0, int sc0, int valid, LAS float* scr, int lane, const float* gk = nullptr) {
    const int c = lane & 31;
    const int cs = c < valid ? c : 0;
    if (gk) {
#pragma unroll 16
        for (int i = 0; i < 32; ++i) { const int kk = 2 * i + (lane >> 5); const float v = W[(size_t)(k0 + kk) * Ns + sc0 + cs] * gk[k0 + kk]; scr[kk * 33 + c] = (c < valid) ? v : 0.f; }
    } else {
#pragma unroll 16
    for (int i = 0; i < 32; ++i) { const int kk = 2 * i + (lane >> 5); const float v = W[(size_t)(k0 + kk) * Ns + sc0 + cs]; scr[kk * 33 + c] = (c < valid) ? v : 0.f; }
    }
    LDS_WAIT(); asm volatile("" ::: "memory");
    const int c8 = lane & 7;
#pragma unroll
    for (int j = 0; j < 4; ++j) { const int n = (lane >> 3) + 8 * j; const LAS float* s = scr + (8 * c8) * 33 + n;
        v4u o; o.x = pk2(s[0 * 33], s[1 * 33]); o.y = pk2(s[2 * 33], s[3 * 33]); o.z = pk2(s[4 * 33], s[5 * 33]); o.w = pk2(s[6 * 33], s[7 * 33]);
        *(GAS v4u*)(WT + (size_t)(n0 + n) * K + k0 + 8 * c8) = o; }
    LDS_WAIT(); asm volatile("" ::: "memory");
}
__device__ __forceinline__ void ev_group(int nb, int& src, int& valid) {
    const int c0 = nb * 32; valid = 32;
    if (c0 < EC_GR) src = 0 + c0;
    else if (c0 < EC_GQ) src = 2760 + (c0 - EC_GR);
    else if (c0 < EC_GK) src = 1224 + (c0 - EC_GQ);
    else if (c0 < EC_GV) src = 1736 + (c0 - EC_GK);
    else if (c0 < EC_IQ) src = 2248 + (c0 - EC_GV);
    else if (c0 < EC_AK) src = 640 + (c0 - EC_IQ);
    else if (c0 < EC_AV) src = 512 + (c0 - EC_AK);
    else if (c0 < EC_IK) src = 576 + (c0 - EC_AV);
    else if (c0 < EC_IW) src = 1152 + (c0 - EC_IK);
    else if (c0 < EC_GLR) { src = 1216; valid = 8; }
    else { src = 3272; valid = 16; }
}
__device__ __forceinline__ void convert_layer(const Frame& F, int l, int parts) {
    CArgs* ap = opq_p(F.ap); unsigned char* ws = as_global(ap->ws);
    PHASE_UNIFORMS(); const int lane = opq_v(lane_id());
    LAS float* scr = (LAS float*)(opq_l(lds_base()) + wave * 16384);
    const int gw = vcu * NWAVES + wave, NGW = G * NWAVES;
    const int j = l >> 1; const bool even = (l & 1) == 0;
    bf16* WIN = (bf16*)(ws + WS_WIN); bf16* WOUT = (bf16*)(ws + WS_WOUT); bf16* W1 = (bf16*)(ws + WS_W1); bf16* W2 = (bf16*)(ws + WS_W2);
    const float* g_in = l > 0 ? as_global(ap->in[I_LN2G]) + (size_t)(l - 1) * DM : nullptr; const float* g_1 = as_global(ap->in[I_LN1G]) + (size_t)l * DM;
    const int n_in = (parts & 1) ? (even ? 16 * (EVW / 32) : 16 * (4096 / 32)) : 0;
    const int n_out = (parts & 10) ? (even ? 16 * 32 : 32 * 32) : 0;
    const int n_1 = (parts & 6) ? 16 * 128 : 0, n_2 = (parts & 10) ? 64 * 32 : 0;
    const int total = n_in + n_out + n_1 + n_2;
    for (int it = gw; it < total; it += NGW) {
        int r = it;
        if (r < n_in) {
            if (even) { const int nblk = EVW / 32, kb = r / nblk, nb = r % nblk; int src, valid; ev_group(nb, src, valid);
                transpose_item(as_global(ap->in[I_EV_WIN]) + (size_t)j * 1024 * EV_SRCW, 1024, EV_SRCW, WIN, 64 * kb, 32 * nb, src, valid, scr, lane, g_in); }
            else { const int nblk = 128, kb = r / nblk, nb = r % nblk;
                transpose_item(as_global(ap->in[I_OD_WIN]) + (size_t)j * 1024 * 4096, 1024, 4096, WIN, 64 * kb, 32 * nb, 32 * nb, 32, scr, lane, g_in); }
            continue; }
        r -= n_in;
        if (r < n_out) { const int kb = r / 32, nb = r % 32;
            if (even) transpose_item(as_global(ap->in[I_EV_WOUT]) + (size_t)j * 1024 * 1024, 1024, 1024, WOUT, 64 * kb, 32 * nb, 32 * nb, 32, scr, lane);
            else transpose_item(as_global(ap->in[I_OD_WOUT]) + (size_t)j * 2048 * 1024, 2048, 1024, WOUT, 64 * kb, 32 * nb, 32 * nb, 32, scr, lane);
            continue; }
        r -= n_out;
        if (r < n_1) { const int kb = r / 128, nb = r % 128; transpose_item(as_global(ap->in[I_W1]) + (size_t)l * 1024 * 4096, 1024, 4096, W1, 64 * kb, 32 * nb, 32 * nb, 32, scr, lane, g_1); continue; }
        r -= n_1;
        { const int kb = r / 32, nb = r % 32; transpose_item(as_global(ap->in[I_W2]) + (size_t)l * 4096 * 1024, 4096, 1024, W2, 64 * kb, 32 * nb, 32 * nb, 32, scr, lane); }
    }
}
__device__ __forceinline__ void colsum_items(const Frame& F, int l, int which) {
    CArgs* ap = opq_p(F.ap); unsigned char* ws = as_global(ap->ws); LAS float* part = (LAS float*)opq_l(lds_base());
    PHASE_UNIFORMS(); const int lane = opq_v(lane_id());
    const int j = l >> 1; const bool even = (l & 1) == 0;
    const float* g; const float* b; const float* W; int Ns, ncol;
    if (which == 0) { g = as_global(ap->in[I_LN2G]) + (size_t)(l - 1) * DM; b = as_global(ap->in[I_LN2B]) + (size_t)(l - 1) * DM;
        if (even) { W = as_global(ap->in[I_EV_WIN]) + (size_t)j * 1024 * EV_SRCW; Ns = EV_SRCW; ncol = EVW; } else { W = as_global(ap->in[I_OD_WIN]) + (size_t)j * 1024 * 4096; Ns = 4096; ncol = 4096; } }
    else { g = as_global(ap->in[I_LN1G]) + (size_t)l * DM; b = as_global(ap->in[I_LN1B]) + (size_t)l * DM; W = as_global(ap->in[I_W1]) + (size_t)l * 1024 * 4096; Ns = 4096; ncol = 4096; }
    float* CS = (float*)(ws + WS_SMALL + SM_COLV) + (which ? 2 * 4096 : 0); float* BB = CS + 4096;
    const int slot = which ? (vcu + G / 2) % G : vcu;
    for (int it = G - 1 - slot; it < ncol / 64; it += G) {
        const int n = 64 * it + lane; int src = n, valid = 32;
        if (which == 0 && even) { ev_group(n >> 5, src, valid); src += (lane & 31) < valid ? (lane & 31) : 0; }
        const bool ok = (lane & 31) < valid;
        const GAS float* wp = (const GAS float*)W + (size_t)(128 * wave) * Ns + src;
        float cs = 0.f, bb = 0.f;
        float wv[128];
#pragma unroll
        for (int kk = 0; kk < 128; ++kk) wv[kk] = wp[(size_t)kk * Ns];
        asm volatile("" ::: "memory"); __builtin_amdgcn_sched_barrier(0);
#pragma unroll
        for (int kk = 0; kk < 128; ++kk) { const float v = wv[kk]; const float gk = g[128 * wave + kk], bk = b[128 * wave + kk];
            const float p = v * gk; cs += bf2f((unsigned short)f2bf(p)); bb += bk * v; }
        __syncthreads();
        part[(wave * 64 + lane) * 2] = ok ? cs : 0.f; part[(wave * 64 + lane) * 2 + 1] = ok ? bb : 0.f;
        __syncthreads();
        if (wave == 0) { float c = 0.f, d = 0.f;
#pragma unroll
            for (int w = 0; w < NWAVES; ++w) { c += part[(w * 64 + lane) * 2]; d += part[(w * 64 + lane) * 2 + 1]; }
            CS[n] = c; BB[n] = d; }
        __syncthreads();
    }
}
__device__ __forceinline__ void fold_small(const Frame& F) {
    CArgs* ap = opq_p(F.ap); unsigned char* ws = as_global(ap->ws);
    PHASE_UNIFORMS(); const int gt = (vcu * NWAVES + wave) * 64 + opq_v(lane_id()), NT = G * NWAVES * 64;
    float* GW = (float*)(ws + WS_SMALL + SM_GATEW); float* KF = (float*)(ws + WS_SMALL + SM_KFOLD);
    for (int i = gt; i < 2 * 2048 * 8; i += NT) {
        const int j = i / (2048 * 8), ch = (i / 8) % 2048, g = i % 8, n = ch >> 2, d = ch & 3;
        const float* wq = as_global(ap->in[I_OD_WQ]) + ((size_t)j * 512 + n) * 16 + d * 4; const float* wk = as_global(ap->in[I_OD_WK]) + ((size_t)j * 512 + n) * 16 + d * 4; const float* wv = as_global(ap->in[I_OD_WV]) + ((size_t)j * 512 + n) * 16 + d * 4;
        const float* wg = as_global(ap->in[I_OD_WGATE]) + (size_t)j * 6144 * 8;
        float sc = 0.f, sm = 0.f;
#pragma unroll
        for (int e = 0; e < 4; ++e) { sc += wq[e] * wg[(size_t)(4 * n + e) * 8 + g] + wk[e] * wg[(size_t)(2048 + 4 * n + e) * 8 + g]; sm += wv[e] * wg[(size_t)(4096 + 4 * n + e) * 8 + g]; }
        GW[((size_t)j * 2 + 0) * 2048 * 8 + ch * 8 + g] = sc; GW[((size_t)j * 2 + 1) * 2048 * 8 + ch * 8 + g] = sm;
    }
    { bf16* W2T = (bf16*)(ws + WS_SMALL + (10 * MiB + 512 * 1024));
      for (int i = gt; i < 2 * 512 * 16; i += NT) { const int j = i / (512 * 16), d = (i / 16) % 512, r = i % 16; W2T[i] = (bf16)f2bf(as_global(ap->in[I_EV_GW2])[((size_t)j * 16 + r) * 512 + d]); } }
    { bf16* GWT = (bf16*)(ws + WS_SMALL + SM_GWT);
      for (int i = gt; i < 2 * 16 * 4096; i += NT) { const int j = i / (16 * 4096), rr = i % (16 * 4096), ksf = rr >> 9, ln = (rr >> 3) & 63, g = ln & 15, ch = 32 * ksf + 8 * (ln >> 4) + (rr & 7); float v = 0.f;
          if (g < 8) { const int n = (ch & 2047) >> 2, d = ch & 3; const float* wg = as_global(ap->in[I_OD_WGATE]) + (size_t)j * 6144 * 8;
              if (ch < 2048) { const float* wq = as_global(ap->in[I_OD_WQ]) + ((size_t)j * 512 + n) * 16 + d * 4; const float* wk = as_global(ap->in[I_OD_WK]) + ((size_t)j * 512 + n) * 16 + d * 4;
#pragma unroll
                  for (int e = 0; e < 4; ++e) v += wq[e] * wg[(size_t)(4 * n + e) * 8 + g] + wk[e] * wg[(size_t)(2048 + 4 * n + e) * 8 + g]; }
              else { const float* wv = as_global(ap->in[I_OD_WV]) + ((size_t)j * 512 + n) * 16 + d * 4;
#pragma unroll
                  for (int e = 0; e < 4; ++e) v += wv[e] * wg[(size_t)(4096 + 4 * n + e) * 8 + g]; } }
          GWT[i] = (bf16)f2bf(v); } }
    for (int i = gt; i < 2 * 512 * 16; i += NT) {
        const int j = i / (512 * 16), n = (i / 16) % 512, ii = (i / 4) % 4, d = i % 4;
        const float* wq = as_global(ap->in[I_OD_WQ]) + ((size_t)j * 512 + n) * 16 + d * 4; const float* wk = as_global(ap->in[I_OD_WK]) + ((size_t)j * 512 + n) * 16 + ii * 4;
        float s = 0.f;
#pragma unroll
        for (int e = 0; e < 4; ++e) s += wk[e] * wq[e];
        KF[i] = s * 0.044194173824159216f;
    }
}
__device__ __forceinline__ void copy_ln_vectors(const Frame& F) {
    CArgs* ap = opq_p(F.ap); unsigned char* ws = as_global(ap->ws); PHASE_UNIFORMS(); const int gt = (vcu * NWAVES + wave) * 64 + opq_v(lane_id());
    if (gt < DEPTH * DM) {
#pragma unroll
        for (int kind = 0; kind < 4; ++kind) ((float*)(ws + pg8::LNW_LNV))[kind * DEPTH * DM + gt] = as_global(ap->in[I_LN1G + kind])[gt]; }
}
__device__ __forceinline__ void x_to_bf16(const Frame& F) {
    CArgs* ap = opq_p(F.ap); unsigned char* ws = as_global(ap->ws); const float* x = as_global(ap->in[I_X]);
    PHASE_UNIFORMS(); const int lane = opq_v(lane_id()); const int gw = vcu * NWAVES + wave, NGW = G * NWAVES; bf16* XB = (bf16*)(ws + WS_XB);
    for (int m0 = gw; m0 < M; m0 += 4 * NGW) {
        f32x4 v[4][4];
#pragma unroll
        for (int r = 0; r < 4; ++r) { const int m = m0 + r * NGW; const GAS f32x4* xr = (const GAS f32x4*)(x + (size_t)(m < M ? m : m0) * DM) + lane;
#pragma unroll
            for (int j = 0; j < 4; ++j) v[r][j] = xr[64 * j]; }
#pragma unroll
        for (int r = 0; r < 4; ++r) { const int m = m0 + r * NGW;
            if (m < M) { GAS unsigned long long* o8 = (GAS unsigned long long*)(XB + (size_t)m * DM) + lane;
#pragma unroll
                for (int j = 0; j < 4; ++j) o8[64 * j] = (unsigned long long)pk2(v[r][j].x, v[r][j].y) | ((unsigned long long)pk2(v[r][j].z, v[r][j].w) << 32); } }
    }
}
__device__ __forceinline__ void ln_phase(const Frame& F, int gi, int bi, int l, bool final_out) {
    CArgs* ap = opq_p(F.ap); unsigned char* ws = as_global(ap->ws); const bf16* T = final_out ? (const bf16*)(ws + WS_XB) : (const bf16*)as_global(ap->out); const float* g = as_global(ap->in[gi]) + (size_t)l * DM; const float* b = as_global(ap->in[bi]) + (size_t)l * DM; float* OUT = final_out ? as_global(ap->out) : nullptr;
    PHASE_UNIFORMS(); const int lane = opq_v(lane_id()); const int gw = vcu * NWAVES + wave, NGW = G * NWAVES; bf16* XB = (bf16*)(ws + WS_XB);
    f32x4 gv[4], bv[4];
#pragma unroll
    for (int j = 0; j < 4; ++j) { gv[j] = ((const GAS f32x4*)g)[lane + 64 * j]; bv[j] = ((const GAS f32x4*)b)[lane + 64 * j]; }
    float pscale = 1.f, pspike = 0.f;
    if (PROBE_GA >= 0 && final_out) { const float* pf = (const float*)(ws + WS_CTL) + 2048; pscale = 1.f + __hip_atomic_load(pf, __ATOMIC_RELAXED, __HIP_MEMORY_SCOPE_AGENT); pspike = 100.f * __hip_atomic_load(pf + 1, __ATOMIC_RELAXED, __HIP_MEMORY_SCOPE_AGENT); }
    v2u nx[2][4];
#pragma unroll
    for (int r = 0; r < 2; ++r) { const int m = gw + r * NGW; const GAS v2u* tr = (const GAS v2u*)(T + (size_t)(m < M ? m : 0) * DM) + lane;
#pragma unroll
        for (int j = 0; j < 4; ++j) nx[r][j] = tr[64 * j]; }
    for (int m0 = gw; m0 < M; m0 += 2 * NGW) {
        v2u cur[2][4];
#pragma unroll
        for (int r = 0; r < 2; ++r)
#pragma unroll
            for (int j = 0; j < 4; ++j) cur[r][j] = nx[r][j];
#pragma unroll
        for (int r = 0; r < 2; ++r) { const int m = m0 + (2 + r) * NGW; const GAS v2u* tr = (const GAS v2u*)(T + (size_t)(m < M ? m : 0) * DM) + lane;
#pragma unroll
            for (int j = 0; j < 4; ++j) nx[r][j] = tr[64 * j]; }
        f32x4 v[2][4]; float s[2] = {0.f, 0.f};
#pragma unroll
        for (int r = 0; r < 2; ++r)
#pragma unroll
            for (int j = 0; j < 4; ++j) { const v2u t = cur[r][j]; v[r][j] = (f32x4){bflo(t.x), bfhi(t.x), bflo(t.y), bfhi(t.y)}; s[r] += (v[r][j].x + v[r][j].y) + (v[r][j].z + v[r][j].w); }
#pragma unroll
        for (int o = 1; o < 64; o <<= 1) { s[0] += shx(s[0], o, lane); s[1] += shx(s[1], o, lane); }
        float s2[2] = {0.f, 0.f};
#pragma unroll
        for (int r = 0; r < 2; ++r) { const float mean = s[r] * (1.f / DM);
#pragma unroll
            for (int j = 0; j < 4; ++j) { v[r][j] = v[r][j] - mean; s2[r] += (v[r][j].x * v[r][j].x + v[r][j].y * v[r][j].y) + (v[r][j].z * v[r][j].z + v[r][j].w * v[r][j].w); } }
#pragma unroll
        for (int o = 1; o < 64; o <<= 1) { s2[0] += shx(s2[0], o, lane); s2[1] += shx(s2[1], o, lane); }
#pragma unroll
        for (int r = 0; r < 2; ++r) { const int m = m0 + r * NGW; if (m < M) { const float rstd = 1.f / sqrtf(s2[r] * (1.f / DM) + LN_EPS);
            GAS unsigned long long* o8 = (GAS unsigned long long*)(XB + (size_t)m * DM) + lane;
#pragma unroll
            for (int j = 0; j < 4; ++j) { const f32x4 y = v[r][j] * rstd * gv[j] + bv[j]; if (!final_out) o8[64 * j] = (unsigned long long)pk2(y.x, y.y) | ((unsigned long long)pk2(y.z, y.w) << 32);
                if (OUT) { f32x4 yo = y * pscale; if (PROBE_GA >= 0 && m == 0 && j == 0 && lane == 0) yo.x += pspike; ((GAS f32x4*)(OUT + (size_t)m * DM))[lane + 64 * j] = yo; } } } }
    }
}
typedef short v4i16_t __attribute__((ext_vector_type(4)));
__device__ __forceinline__ s16x4 tr4(const LAS unsigned char* p) { return __builtin_bit_cast(s16x4, __builtin_amdgcn_ds_read_tr16_b64_v4i16((LAS v4i16_t*)p)); }
__device__ __forceinline__ bf16x8 tr_frag(const LAS unsigned char* T, int pitch, int k0, int n0, int lane) {
    const int g = lane >> 4, q = (lane & 15) >> 2, p = lane & 3;
    const LAS unsigned char* a = T + (k0 + 8 * g + q) * pitch + (n0 + 4 * p) * 2;
    const s16x4 lo = tr4(a), hi = tr4(a + 4 * pitch);
    return (bf16x8){lo[0], lo[1], lo[2], lo[3], hi[0], hi[1], hi[2], hi[3]};
}
__device__ __forceinline__ void lds_fadd(LAS float* p, float v) { (void)__hip_atomic_fetch_add(p, v, __ATOMIC_RELAXED, __HIP_MEMORY_SCOPE_WORKGROUP); }

__device__ __forceinline__ size_t xct_frag(size_t tb16, int cb) { return (tb16 * 64 + (size_t)cb) * 512; }
__device__ __forceinline__ size_t xct_elem(size_t m, int ch) { return ((m >> 4) * 64 + (size_t)(ch >> 5)) * 512 + (size_t)((((ch >> 3) & 3) * 16 + (int)(m & 15)) * 8 + (ch & 7)); }
__device__ __forceinline__ void o2_conv(const Frame& F, int j) {
    CArgs* ap = opq_p(F.ap); unsigned char* ws = as_global(ap->ws); LAS unsigned char* lds = opq_l(lds_base()); PHASE_UNIFORMS();
    const int lane = opq_v(lane_id()), tid = wave * 64 + lane, g4 = lane >> 4, l15 = lane & 15;
    bf16* XM = (bf16*)(ws + WS_BIG); bf16* XC = XM + (size_t)M * MI; bf16* KT = XC + (size_t)M * MI;
    const float* cw = as_global(ap->in[I_OD_CONVW]) + (size_t)j * 4 * MI; const float* cb = as_global(ap->in[I_OD_CONVB]) + (size_t)j * MI;
    const float* KF = (const float*)(ws + WS_SMALL + SM_KFOLD) + (size_t)j * 512 * 16;
    const bf16* GWT = (const bf16*)(ws + WS_SMALL + SM_GWT) + (size_t)j * 16 * 4096;
    const float* bg = as_global(ap->in[I_OD_BGATE]) + j * 8;
    float* LI = (float*)(ws + WS_SMALL + SM_LI); float* BC = (float*)(ws + WS_SMALL + SM_BC); float* CHG = (float*)(ws + WS_SMALL + SM_CHG);
    const int n = tid, ch0 = 4 * n, hh = n >> 7, dd0 = 4 * (n & 127);
    float w[4][4], cbv[4], kf[16];
#pragma unroll
    for (int k = 0; k < 4; ++k)
#pragma unroll
        for (int c = 0; c < 4; ++c) w[k][c] = cw[k * MI + ch0 + c];
#pragma unroll
    for (int c = 0; c < 4; ++c) cbv[c] = cb[ch0 + c];
#pragma unroll
    for (int i = 0; i < 16; ++i) kf[i] = KF[n * 16 + i];
    LAS unsigned char* Xl = lds;
    LAS unsigned char* Xml = lds + 65792;
    LAS float* gpart = (LAS float*)(lds + 131584);
    LAS float* gat = (LAS float*)(lds + 139776);
    bf16x8 Bg0[8];
#pragma unroll
    for (int k8 = 0; k8 < 8; ++k8) Bg0[k8] = *(const bf16x8*)(GWT + ((size_t)(8 * wave + k8) * 64 + lane) * 8);
    for (int u = bid; u < BATCH * NCH; u += G) {
        const int b = u >> 6, c = u & 63, t0 = c * MCH; const size_t m0 = (size_t)b * SEQ + t0;
        float p3[4], p2[4], p1[4];
        { uint2 r3 = make_uint2(0u, 0u), r2 = r3, r1 = r3;
          if (c > 0) { r3 = *(const uint2*)(XM + (m0 - 3) * MI + ch0); r2 = *(const uint2*)(XM + (m0 - 2) * MI + ch0); r1 = *(const uint2*)(XM + (m0 - 1) * MI + ch0); }
          p3[0] = bflo(r3.x); p3[1] = bfhi(r3.x); p3[2] = bflo(r3.y); p3[3] = bfhi(r3.y);
          p2[0] = bflo(r2.x); p2[1] = bfhi(r2.x); p2[2] = bflo(r2.y); p2[3] = bfhi(r2.y);
          p1[0] = bflo(r1.x); p1[1] = bfhi(r1.x); p1[2] = bflo(r1.y); p1[3] = bfhi(r1.y); }
        uint2 nxt[8];
#pragma unroll
        for (int i = 0; i < 8; ++i) nxt[i] = *(const uint2*)(XM + (m0 + i) * MI + ch0);
        for (int tb = 0; tb < 8; ++tb) {
            uint2 raw[8];
#pragma unroll
            for (int i = 0; i < 8; ++i) raw[i] = nxt[i];
            { const int tn = tb < 7 ? tb + 1 : tb;
#pragma unroll
              for (int i = 0; i < 8; ++i) nxt[i] = *(const uint2*)(XM + (m0 + 8 * tn + i) * MI + ch0); }
            float kq[4][8];
#pragma unroll
            for (int i = 0; i < 8; ++i) {
                float x0[4] = {bflo(raw[i].x), bfhi(raw[i].x), bflo(raw[i].y), bfhi(raw[i].y)}, xc[4];
#pragma unroll
                for (int cc = 0; cc < 4; ++cc) { const float z = w[0][cc] * p3[cc] + w[1][cc] * p2[cc] + w[2][cc] * p1[cc] + w[3][cc] * x0[cc] + cbv[cc]; xc[cc] = z * sigmoidf_(z); }
                *(LAS v2u*)(Xl + (8 * (tb & 1) + i) * 4112 + ch0 * 2) = (v2u){pk2(xc[0], xc[1]), pk2(xc[2], xc[3])};
                *(LAS v2u*)(Xml + (8 * (tb & 1) + i) * 4112 + ch0 * 2) = (v2u){raw[i].x, raw[i].y};
#pragma unroll
                for (int d = 0; d < 4; ++d) kq[d][i] = xc[0] * kf[0 * 4 + d] + xc[1] * kf[1 * 4 + d] + xc[2] * kf[2 * 4 + d] + xc[3] * kf[3 * 4 + d];
#pragma unroll
                for (int cc = 0; cc < 4; ++cc) { p3[cc] = p2[cc]; p2[cc] = p1[cc]; p1[cc] = x0[cc]; }
            }
#pragma unroll
            for (int d = 0; d < 4; ++d) { v4u o; o.x = pk2(kq[d][0], kq[d][1]); o.y = pk2(kq[d][2], kq[d][3]); o.z = pk2(kq[d][4], kq[d][5]); o.w = pk2(kq[d][6], kq[d][7]);
                *(v4u*)(KT + (size_t)((b * MH + hh) * NCH + c) * MDH * MCH + ((((dd0 + d) >> 4) * 2 + (tb >> 2)) * 64 + (tb & 3) * 16 + ((dd0 + d) & 15)) * 8) = o; }
            if (tb & 1) {
                __syncthreads();
                bf16x8 Bg1[8];
#pragma unroll
                for (int k8 = 0; k8 < 8; ++k8) Bg1[k8] = *(const bf16x8*)(GWT + ((size_t)(64 + 8 * wave + k8) * 64 + lane) * 8);
                asm volatile("" ::: "memory"); __builtin_amdgcn_sched_barrier(0);
                bf16* dst = XC + xct_frag((m0 >> 4) + (tb >> 1), 0);
#pragma unroll
                for (int k8 = 0; k8 < 8; ++k8) { const int p = tid + 512 * k8, cbk = p >> 6, sl = p & 63; *(v4u*)(dst + (size_t)p * 8) = *(const LAS v4u*)(Xl + (sl & 15) * 4112 + (cbk * 32 + 8 * (sl >> 4)) * 2); }
                { f32x4 acc = zero4();
#pragma unroll
                  for (int hf = 0; hf < 2; ++hf)
#pragma unroll
                      for (int k8 = 0; k8 < 8; ++k8) { const bf16x8 A = *(const LAS bf16x8*)((hf ? Xml : Xl) + l15 * 4112 + (256 * wave + 32 * k8 + 8 * g4) * 2);
                          acc = MFMA16(A, hf ? Bg1[k8] : Bg0[k8], acc); }
#pragma unroll
                  for (int i = 0; i < 4; ++i) gpart[(wave * 16 + 4 * g4 + i) * 16 + l15] = acc[i]; }
                __syncthreads();
                if (tid < 128) { const int tk = tid >> 3, g = tid & 7; float s = bg[g];
#pragma unroll
                    for (int w8 = 0; w8 < 8; ++w8) s += gpart[(w8 * 16 + tk) * 16 + g];
                    gat[(16 * (tb >> 1) + tk) * 8 + g] = s; }
            }
        }
        __syncthreads();
        if (wave < MH) { const int hd = wave; const size_t o = (size_t)(b * MH + hd) * SEQ + t0;
            const float li = gat[lane * 8 + hd]; float bc = logsigmoidf_(gat[lane * 8 + 4 + hd]);
#pragma unroll
            for (int of = 1; of < 64; of <<= 1) { const float v = shi(bc, lane >= of ? lane - of : lane); if (lane >= of) bc += v; }
            LI[o + lane] = li; BC[o + lane] = bc;
            float mx = li - bc;
#pragma unroll
            for (int of = 1; of < 64; of <<= 1) mx = fmaxf(mx, shx(mx, of, lane));
            const float gtot = shi(bc, 63);
            if (lane == 0) { CHG[((size_t)(b * MH + hd) * NCH + c) * 2 + 0] = gtot; CHG[((size_t)(b * MH + hd) * NCH + c) * 2 + 1] = gtot + mx; } }
        __syncthreads();
    }
}

__device__ __forceinline__ void o3_pphase(const Frame& F) {
    CArgs* ap = opq_p(F.ap); unsigned char* ws = as_global(ap->ws); LAS unsigned char* lds = opq_l(lds_base()); PHASE_UNIFORMS();
    const int lane = opq_v(lane_id()), tid = wave * 64 + lane, g4 = lane >> 4, l15 = lane & 15;
    const bf16* XC = (const bf16*)(ws + WS_BIG) + (size_t)M * MI; const bf16* KT = XC + (size_t)M * MI;
    bf16* Pg = (bf16*)(ws + WS_AUX);
    const float* LI = (const float*)(ws + WS_SMALL + SM_LI); const float* BC = (const float*)(ws + WS_SMALL + SM_BC); const float* CHG = (const float*)(ws + WS_SMALL + SM_CHG);
    float* WIN_ = (float*)(ws + WS_SMALL + SM_WIN); float* DEN = (float*)(ws + WS_SMALL + SM_DEN); float* EMM = (float*)(ws + WS_SMALL + SM_EMM); float* WK = (float*)(ws + WS_SMALL + SM_WK); float* DEC = (float*)(ws + WS_SMALL + SM_DEC);
    LAS unsigned char* KL = lds;
    LAS float* sbt = (LAS float*)(lds + 80 * 1024); LAS float* sli = sbt + 64; LAS float* smt = sbt + 128; LAS float* sden = sbt + 192;
    LAS unsigned char* Pt = lds + 84 * 1024;
    const int mb = wave >> 1;
    bf16x8 Aq[16]; v4u kreg[8]; float gi = 0.f, ai = 0.f, bt = 0.f, li = 0.f;
    { const int u = vcu < BATCH * MH * NCH ? vcu : 0; const int bh = u >> 6, c = u & 63; const size_t m0 = (size_t)(bh >> 2) * SEQ + c * MCH; const bf16* src = KT + (size_t)u * MDH * MCH;
#pragma unroll
      for (int ks = 0; ks < 16; ++ks) Aq[ks] = *(const bf16x8*)(XC + xct_frag((m0 >> 4) + mb, (bh & 3) * 16 + ks) + lane * 8);
#pragma unroll
      for (int i = 0; i < 8; ++i) { const int p = tid + 512 * i; kreg[i] = *(const v4u*)(src + p * 8); }
      if (wave == 0) { gi = CHG[((size_t)bh * NCH + lane) * 2 + 0]; ai = CHG[((size_t)bh * NCH + lane) * 2 + 1]; bt = BC[(size_t)bh * SEQ + c * MCH + lane]; li = LI[(size_t)bh * SEQ + c * MCH + lane]; } }
    for (int u = vcu; u < BATCH * MH * NCH; u += G) {
        const int bh = u >> 6, c = u & 63, b = bh >> 2, h = bh & 3; const size_t m0 = (size_t)b * SEQ + c * MCH; (void)b; (void)h; (void)m0;
        const int un = u + G < BATCH * MH * NCH ? u + G : u, bhn = un >> 6, cn = un & 63; const size_t m0n = (size_t)(bhn >> 2) * SEQ + cn * MCH;
#pragma unroll
        for (int i = 0; i < 8; ++i) { const int p = tid + 512 * i, f = p >> 6, sl = p & 63, row = 16 * (f >> 1) + (sl & 15), s0 = 32 * (f & 1) + 8 * (sl >> 4); *(LAS v4u*)(KL + row * 144 + s0 * 2) = kreg[i]; }
        { const bf16* src = KT + (size_t)un * MDH * MCH;
#pragma unroll
          for (int i = 0; i < 8; ++i) { const int p = tid + 512 * i; kreg[i] = *(const v4u*)(src + p * 8); } }
        if (wave == 0) {
            float pg = gi, pa = ai;
#pragma unroll
            for (int o = 1; o < 64; o <<= 1) { const float g_ = shi(pg, lane >= o ? lane - o : lane), a_ = shi(pa, lane >= o ? lane - o : lane);
                if (lane >= o) { pa = fmaxf(pg + a_, pa); pg = pg + g_; } }
            const float mincl = fmaxf(pg, pa);
            const float m = c > 0 ? shi(mincl, c - 1) : 0.f;
            float pm = li - bt;
#pragma unroll
            for (int o = 1; o < 64; o <<= 1) { const float v = shi(pm, lane >= o ? lane - o : lane); if (lane >= o) pm = fmaxf(pm, v); }
            const float mt = bt + fmaxf(m, pm);
            const float g = shi(bt, 63), pm63 = shi(pm, 63), mnew = g + fmaxf(m, pm63);
            const size_t o = (size_t)bh * SEQ + c * MCH + lane;
            WIN_[o] = __expf(bt + m - mt); EMM[o] = __expf(-mt); WK[o] = __expf(g - bt + li - mnew);
            if (lane == 0) DEC[bh * NCH + c] = __expf(g + m - mnew);
            sbt[lane] = bt; sli[lane] = li; smt[lane] = mt;
            gi = CHG[((size_t)bhn * NCH + lane) * 2 + 0]; ai = CHG[((size_t)bhn * NCH + lane) * 2 + 1]; bt = BC[(size_t)bhn * SEQ + cn * MCH + lane]; li = LI[(size_t)bhn * SEQ + cn * MCH + lane];
        }
        __syncthreads();
        f32x4 acc[2] = {zero4(), zero4()};
#pragma unroll
        for (int ks = 0; ks < 16; ++ks) {
#pragma unroll
            for (int nn = 0; nn < 2; ++nn) { const int nb = 2 * (wave & 1) + nn;
                if (nb <= mb) { const bf16x8 B = tr_frag(KL, 144, 32 * ks, 16 * nb, lane); acc[nn] = MFMA16(Aq[ks], B, acc[nn]); } }
        }
#pragma unroll
        for (int ks = 0; ks < 16; ++ks) Aq[ks] = *(const bf16x8*)(XC + xct_frag((m0n >> 4) + mb, (bhn & 3) * 16 + ks) + lane * 8);
        float rs[4] = {0.f, 0.f, 0.f, 0.f};
#pragma unroll
        for (int nn = 0; nn < 2; ++nn) { const int nb = 2 * (wave & 1) + nn, s = 16 * nb + l15; const float bs = sbt[s], ls = sli[s];
#pragma unroll
            for (int i = 0; i < 4; ++i) { const int t = 16 * mb + 4 * g4 + i; float p = 0.f;
                if (nb <= mb && s <= t) p = __expf(sbt[t] - bs + ls - smt[t]) * acc[nn][i];
                rs[i] += p; *(LAS unsigned short*)(Pt + t * 144 + s * 2) = (unsigned short)f2bf(p); } }
#pragma unroll
        for (int i = 0; i < 4; ++i) { float r = rs[i]; r += shx(r, 1, lane); r += shx(r, 2, lane); r += shx(r, 4, lane); r += shx(r, 8, lane);
            if (l15 == 0) sden[(wave & 1) * 64 + 16 * mb + 4 * g4 + i] = r; }
        __syncthreads();
        if (tid < 64) DEN[(size_t)bh * SEQ + c * MCH + tid] = sden[tid] + sden[64 + tid];
        *(v4u*)(Pg + ((size_t)u * 64 + (tid >> 3)) * 64 + 8 * (tid & 7)) = *(const LAS v4u*)(Pt + (tid >> 3) * 144 + (tid & 7) * 16);
        __syncthreads();
    }
}

__device__ __forceinline__ void o4_scan(const Frame& F, int j) {
    CArgs* ap = opq_p(F.ap); unsigned char* ws = as_global(ap->ws); LAS unsigned char* lds = opq_l(lds_base()); PHASE_UNIFORMS();
    const int lane = opq_v(lane_id()), tid = wave * 64 + lane, g4 = lane >> 4, l15 = lane & 15;
    bf16* XM = (bf16*)(ws + WS_BIG); const bf16* XC = XM + (size_t)M * MI; const bf16* KT = XC + (size_t)M * MI;
    const bf16* Pg = (const bf16*)(ws + WS_AUX); const bf16* OG = (const bf16*)as_global(ap->out);
    const float* WIN_ = (const float*)(ws + WS_SMALL + SM_WIN); const float* DEN = (const float*)(ws + WS_SMALL + SM_DEN); const float* EMM = (const float*)(ws + WS_SMALL + SM_EMM);
    const float* WK = (const float*)(ws + WS_SMALL + SM_WK); const float* DEC = (const float*)(ws + WS_SMALL + SM_DEC);
    const float* wvp = as_global(ap->in[I_OD_WV]) + (size_t)j * 512 * 16;
    LAS unsigned char* Vl = lds;
    LAS unsigned char* VTl = lds + 9216;
    LAS unsigned char* Pl = lds + 20480;
    LAS unsigned char* Ct = lds + 29696;
    LAS float* Hp = (LAS float*)(lds + 112896);
    LAS float* swin = (LAS float*)(lds + 112896 + 21504); LAS float* sden = swin + 64; LAS float* semm = swin + 128;
    LAS float* Wl = swin + 192;
    LAS float* Hp1 = (LAS float*)(lds + 136192);
    constexpr int CP = 1040, HP = 84;
#define GLD(T, base, off) (*(const GAS T*)((const GAS char*)(base) + (unsigned)(off)))
    const int wr = (wave + (vcu & 7)) & 7;
    const int vs = tid >> 3, ve0 = 8 * (tid & 7), mb = wr >> 1, kh = wr & 1;
    const unsigned xo = (unsigned)(vs * MI + ve0) * 2u, po = (unsigned)(vs * 64 + ve0) * 2u, so4 = (unsigned)vs * 4u, to4 = (unsigned)(tid & 63) * 4u;
    const unsigned qo = (unsigned)((mb * 64 + 8 * kh) * 512 + lane * 8) * 2u,
                    ko = (unsigned)(wr * 8 * 512 + lane * 8) * 2u;
    for (int u = vcu; u < BATCH * MH * 8; u += G) {
        const int bh = u >> 3, es = u & 7, b = bh >> 2, h = bh & 3, col0 = h * MDH + es * 64;
        f32x4 Cacc[4][5];
#pragma unroll
        for (int db = 0; db < 4; ++db)
#pragma unroll
            for (int nb = 0; nb < 5; ++nb) Cacc[db][nb] = zero4();
        { unsigned wo = (unsigned)(tid & 255) * 4u; asm volatile("" : "+v"(wo)); Wl[tid & 255] = GLD(float, wvp + (size_t)(col0 / 4) * 16, wo); }
        const size_t mrow0 = (size_t)b * SEQ, srow0 = (size_t)bh * SEQ;
        unsigned xo0 = xo, po0 = po, so0 = so4, to0 = to4, qo0 = qo;
        asm volatile("" : "+v"(xo0), "+v"(po0), "+v"(so0), "+v"(to0), "+v"(qo0));
        v4u xr = GLD(v4u, XM + mrow0 * MI + col0, xo0), pr = GLD(v4u, Pg + (size_t)(bh * NCH) * 4096, po0);
        float wks = GLD(float, WK + srow0, so0), s_win = 0.f, s_den = 0.f, s_emm = 0.f;
        if (tid < 64) { s_win = GLD(float, WIN_ + srow0, to0); s_den = GLD(float, DEN + srow0, to0); s_emm = GLD(float, EMM + srow0, to0); }
        bf16x8 qf[8];
#pragma unroll
        for (int ks = 0; ks < 8; ++ks) qf[ks] = GLD(bf16x8, XC + xct_frag(mrow0 >> 4, h * 16), qo0 + 1024u * ks);
        __syncthreads();
        for (int c = 0; c < NCH; ++c) {
            const size_t m0 = mrow0 + c * MCH;
            unsigned xo_ = xo, po_ = po, so_ = so4, to_ = to4, qo_ = qo, ko_ = ko;
            asm volatile("" : "+v"(xo_), "+v"(po_), "+v"(so_), "+v"(to_), "+v"(qo_), "+v"(ko_));
            { float x[8] = {bflo(xr.x), bfhi(xr.x), bflo(xr.y), bfhi(xr.y), bflo(xr.z), bfhi(xr.z), bflo(xr.w), bfhi(xr.w)}, v[8];
#pragma unroll
              for (int blk = 0; blk < 2; ++blk) { const LAS f32x4* wv = (const LAS f32x4*)(Wl + (ve0 / 4 + blk) * 16); const f32x4 w0 = wv[0], w1 = wv[1], w2 = wv[2], w3 = wv[3];
#pragma unroll
                  for (int e = 0; e < 4; ++e) v[4 * blk + e] = x[4 * blk + 0] * w0[e] + x[4 * blk + 1] * w1[e] + x[4 * blk + 2] * w2[e] + x[4 * blk + 3] * w3[e]; }
              v4u o; o.x = pk2(v[0], v[1]); o.y = pk2(v[2], v[3]); o.z = pk2(v[4], v[5]); o.w = pk2(v[6], v[7]);
              *(LAS v4u*)(Vl + vs * 144 + ve0 * 2) = o;
              o.x = pk2(wks * v[0], wks * v[1]); o.y = pk2(wks * v[2], wks * v[3]); o.z = pk2(wks * v[4], wks * v[5]); o.w = pk2(wks * v[6], wks * v[7]);
              *(LAS v4u*)(VTl + vs * 176 + ve0 * 2) = o;
              if ((tid & 7) == 0) { unsigned zz; asm volatile("v_mov_b32 %0, 0" : "=v"(zz)); v4u z; z.x = f2bf(wks); z.y = zz; z.z = zz; z.w = zz; *(LAS v4u*)(VTl + vs * 176 + 128) = z; z.x = zz; *(LAS v4u*)(VTl + vs * 176 + 144) = z; }
              *(LAS v4u*)(Pl + vs * 144 + ve0 * 2) = pr;
              if (tid < 64) { swin[tid] = s_win; sden[tid] = s_den; semm[tid] = s_emm; } }
#pragma unroll
            for (int db = 0; db < 4; ++db)
#pragma unroll
                for (int nb = 0; nb < 5; ++nb) *(LAS v2u*)(Ct + (16 * nb + l15) * CP + (16 * (2 * (db & 1) + (g4 >> 1)) + 2 * wr + (db >> 1)) * 16 + 8 * (g4 & 1)) = (v2u){pk2(Cacc[db][nb][0], Cacc[db][nb][1]), pk2(Cacc[db][nb][2], Cacc[db][nb][3])};
            const v4u og = GLD(v4u, OG + m0 * MI + col0, xo_); const float decay = DEC[bh * NCH + c];
            __syncthreads();
            f32x4 acc[5];
#pragma unroll
            for (int nb = 0; nb < 5; ++nb) acc[nb] = zero4();
            { bf16x8 Bq[2][5];
#pragma unroll
              for (int nb = 0; nb < 5; ++nb) Bq[0][nb] = *(const LAS bf16x8*)(Ct + (16 * nb + l15) * CP + (16 * g4 + 8 * kh) * 16);
#pragma unroll
              for (int ks = 0; ks < 8; ++ks) {
                  if (ks < 7) {
#pragma unroll
                      for (int nb = 0; nb < 5; ++nb) Bq[(ks + 1) & 1][nb] = *(const LAS bf16x8*)(Ct + (16 * nb + l15) * CP + (16 * g4 + 8 * kh + ks + 1) * 16); }
                  asm volatile("" ::: "memory"); __builtin_amdgcn_sched_barrier(0);
#pragma unroll
                  for (int nb = 0; nb < 5; ++nb) acc[nb] = MFMA16(qf[ks], Bq[ks & 1][nb], acc[nb]);
                  asm volatile("" ::: "memory"); __builtin_amdgcn_sched_barrier(0); } }
            bf16x8 kf[4][2];
#pragma unroll
            for (int db = 0; db < 4; ++db)
#pragma unroll
                for (int ks = 0; ks < 2; ++ks) kf[db][ks] = GLD(bf16x8, KT + (size_t)(bh * NCH + c) * MDH * MCH, ko_ + 1024u * (2 * db + ks));
            { const int cn = c + 1 < NCH ? c + 1 : c; const size_t mn = mrow0 + cn * MCH, sn = srow0 + cn * MCH;
#pragma unroll
              for (int ks = 0; ks < 8; ++ks) qf[ks] = GLD(bf16x8, XC + xct_frag(mn >> 4, h * 16), qo_ + 1024u * ks);
              xr = GLD(v4u, XM + mn * MI + col0, xo_); pr = GLD(v4u, Pg + (size_t)(bh * NCH + cn) * 4096, po_);
              wks = GLD(float, WK + sn, so_); if (tid < 64) { s_win = GLD(float, WIN_ + sn, to_); s_den = GLD(float, DEN + sn, to_); s_emm = GLD(float, EMM + sn, to_); } }
            { float wi[4];
#pragma unroll
              for (int i = 0; i < 4; ++i) wi[i] = swin[16 * mb + 4 * g4 + i];
#pragma unroll
              for (int nb = 0; nb < 5; ++nb)
#pragma unroll
                  for (int i = 0; i < 4; ++i) acc[nb][i] *= wi[i]; }
            { const bf16x8 A = *(const LAS bf16x8*)(Pl + (16 * mb + l15) * 144 + (32 * kh + 8 * g4) * 2);
#pragma unroll
              for (int nb = 0; nb < 4; ++nb) { const bf16x8 B = tr_frag(Vl, 144, 32 * kh, 16 * nb, lane); acc[nb] = MFMA16(A, B, acc[nb]); } }
            { LAS float* hp = kh ? Hp1 : Hp;
#pragma unroll
              for (int nb = 0; nb < 5; ++nb)
#pragma unroll
                  for (int i = 0; i < 4; ++i) hp[(16 * mb + 4 * g4 + i) * HP + 16 * nb + l15] = acc[nb][i]; }
            __syncthreads();
            { const float dn = (Hp[vs * HP + 64] + Hp1[vs * HP + 64]) + sden[vs], rd = 1.0f / fmaxf(fabsf(dn), semm[vs]);
              const f32x4 h0 = *(const LAS f32x4*)(Hp + vs * HP + ve0) + *(const LAS f32x4*)(Hp1 + vs * HP + ve0), h1 = *(const LAS f32x4*)(Hp + vs * HP + ve0 + 4) + *(const LAS f32x4*)(Hp1 + vs * HP + ve0 + 4);
              v4u o; o.x = pk2(h0[0] * rd * bflo(og.x), h0[1] * rd * bfhi(og.x)); o.y = pk2(h0[2] * rd * bflo(og.y), h0[3] * rd * bfhi(og.y));
              o.z = pk2(h1[0] * rd * bflo(og.z), h1[1] * rd * bfhi(og.z)); o.w = pk2(h1[2] * rd * bflo(og.w), h1[3] * rd * bfhi(og.w));
              *(GAS v4u*)((GAS char*)(XM + m0 * MI + col0) + xo_) = o; }
#pragma unroll
            for (int db = 0; db < 4; ++db)
#pragma unroll
                for (int nb = 0; nb < 5; ++nb) Cacc[db][nb] = Cacc[db][nb] * decay;
            { bf16x8 Bu[2][2];
#pragma unroll
              for (int ks = 0; ks < 2; ++ks) Bu[0][ks] = tr_frag(VTl, 176, 32 * ks, 0, lane);
#pragma unroll
              for (int nb = 0; nb < 5; ++nb) {
                  if (nb < 4) {
#pragma unroll
                      for (int ks = 0; ks < 2; ++ks) Bu[(nb + 1) & 1][ks] = tr_frag(VTl, 176, 32 * ks, 16 * (nb + 1), lane); }
                  asm volatile("" ::: "memory"); __builtin_amdgcn_sched_barrier(0);
#pragma unroll
                  for (int ks = 0; ks < 2; ++ks)
#pragma unroll
                      for (int db = 0; db < 4; ++db) Cacc[db][nb] = MFMA16(kf[db][ks], Bu[nb & 1][ks], Cacc[db][nb]);
                  asm volatile("" ::: "memory"); __builtin_amdgcn_sched_barrier(0); } }
            __syncthreads();
        }
    }
#undef GLD
}

__device__ __forceinline__ void o5_norm(const Frame& F, int j) {
    CArgs* ap = opq_p(F.ap); unsigned char* ws = as_global(ap->ws); LAS unsigned char* lds = opq_l(lds_base()); PHASE_UNIFORMS();
    const int lane = opq_v(lane_id()), tid = wave * 64 + lane, g4 = lane >> 4, l15 = lane & 15; const int gw = vcu * NWAVES + wave, NGW = G * NWAVES;
    bf16* HB = (bf16*)(ws + WS_BIG); const bf16* XC = HB + (size_t)M * MI;
    const float* ng = as_global(ap->in[I_OD_NORM]) + (size_t)j * MI; const float* sk = as_global(ap->in[I_OD_SKIP]) + (size_t)j * MI;
    LAS float* ngl = (LAS float*)lds; LAS float* skl = ngl + MI;
    for (int i = tid; i < MI; i += 512) { ngl[i] = ng[i]; skl[i] = sk[i]; }
    __syncthreads();
    for (int blk = gw; blk < (M / 16) * MH; blk += NGW) {
        const int tb = blk >> 2, h = blk & 3; const size_t m = (size_t)tb * 16 + l15;
        bf16* hrow = HB + m * MI + h * MDH + 8 * g4;
        v4u hq[16], xq[16];
#pragma unroll
        for (int cb = 0; cb < 16; ++cb) { hq[cb] = *(const v4u*)(hrow + 32 * cb); xq[cb] = *(const v4u*)(XC + xct_frag((size_t)tb, h * 16 + cb) + lane * 8); }
        float s = 0.f;
#pragma unroll
        for (int cb = 0; cb < 16; ++cb) s += ((bflo(hq[cb].x) + bfhi(hq[cb].x)) + (bflo(hq[cb].y) + bfhi(hq[cb].y))) + ((bflo(hq[cb].z) + bfhi(hq[cb].z)) + (bflo(hq[cb].w) + bfhi(hq[cb].w)));
        s += shx(s, 16, lane); s += shx(s, 32, lane);
#pragma unroll
        for (int cb = 0; cb < 16; ++cb) asm volatile("" : "+v"(hq[cb].x), "+v"(hq[cb].y), "+v"(hq[cb].z), "+v"(hq[cb].w));
        const float mean = s * (1.f / MDH); float s2 = 0.f;
#pragma unroll
        for (int cb = 0; cb < 16; ++cb) { const float a0 = bflo(hq[cb].x) - mean, a1 = bfhi(hq[cb].x) - mean, a2 = bflo(hq[cb].y) - mean, a3 = bfhi(hq[cb].y) - mean, a4 = bflo(hq[cb].z) - mean, a5 = bfhi(hq[cb].z) - mean, a6 = bflo(hq[cb].w) - mean, a7 = bfhi(hq[cb].w) - mean;
            s2 += ((a0 * a0 + a1 * a1) + (a2 * a2 + a3 * a3)) + ((a4 * a4 + a5 * a5) + (a6 * a6 + a7 * a7)); }
        s2 += shx(s2, 16, lane); s2 += shx(s2, 32, lane);
#pragma unroll
        for (int cb = 0; cb < 16; ++cb) asm volatile("" : "+v"(hq[cb].x), "+v"(hq[cb].y), "+v"(hq[cb].z), "+v"(hq[cb].w));
        const float rstd = 1.f / sqrtf(s2 * (1.f / MDH) + LN_EPS);
#pragma unroll
        for (int cb = 0; cb < 16; ++cb) { const int c0 = h * MDH + 32 * cb + 8 * g4;
            const f32x4 g0 = *(const LAS f32x4*)(ngl + c0), g1 = *(const LAS f32x4*)(ngl + c0 + 4), k0 = *(const LAS f32x4*)(skl + c0), k1 = *(const LAS f32x4*)(skl + c0 + 4);
            const float hv[8] = {bflo(hq[cb].x), bfhi(hq[cb].x), bflo(hq[cb].y), bfhi(hq[cb].y), bflo(hq[cb].z), bfhi(hq[cb].z), bflo(hq[cb].w), bfhi(hq[cb].w)};
            const float xv[8] = {bflo(xq[cb].x), bfhi(xq[cb].x), bflo(xq[cb].y), bfhi(xq[cb].y), bflo(xq[cb].z), bfhi(xq[cb].z), bflo(xq[cb].w), bfhi(xq[cb].w)};
            float y[8];
#pragma unroll
            for (int e = 0; e < 4; ++e) { y[e] = (hv[e] - mean) * rstd * g0[e] + k0[e] * xv[e]; y[4 + e] = (hv[4 + e] - mean) * rstd * g1[e] + k1[e] * xv[4 + e]; }
            v4u ov; ov.x = pk2(y[0], y[1]); ov.y = pk2(y[2], y[3]); ov.z = pk2(y[4], y[5]); ov.w = pk2(y[6], y[7]);
            *(v4u*)(hrow + 32 * cb) = ov; }
    }
}

__device__ __forceinline__ void odd_mixer(const Frame& F, int j, const XcdBarrier& bar) {
    o2_conv(F, j);
    xcd_barrier(bar, F.wave); STAMP(7);
    o3_pphase(F);
    xcd_barrier(bar, F.wave); STAMP(8);
    o4_scan(F, j);
    xcd_barrier(bar, F.wave); STAMP(9);
    o5_norm(F, j);
    xcd_barrier(bar, F.wave); STAMP(10);
}
constexpr size_t EV_LT_OFF = (size_t)M * EVW * 2;
constexpr size_t SM_GD = 9 * MiB;
constexpr size_t SM_W2T = 10 * MiB + 512 * 1024;

__device__ __forceinline__ unsigned mono_key(float f) { const unsigned u = __float_as_uint(f); return (u & 0x80000000u) ? ~u : (u | 0x80000000u); }

template <int B, int N> __device__ __forceinline__ int count_ge16(const unsigned (&k)[N], unsigned cand) {
    unsigned long long m[16];
#pragma unroll
    for (int i = 0; i < 16; ++i) asm volatile("v_cmp_ge_u32_e64 %0, %1, %2" : "=s"(m[i]) : "v"(k[B + i]), "v"(cand));
    __builtin_amdgcn_sched_barrier(0);
    int c = 0;
#pragma unroll
    for (int i = 0; i < 16; ++i) c += __builtin_popcountll(m[i]);
    __builtin_amdgcn_sched_barrier(0);
    return c;
}
template <int B, int N> __device__ __forceinline__ int count_gt16(const unsigned (&k)[N], unsigned cand) {
    unsigned long long m[16];
#pragma unroll
    for (int i = 0; i < 16; ++i) asm volatile("v_cmp_gt_u32_e64 %0, %1, %2" : "=s"(m[i]) : "v"(k[B + i]), "v"(cand));
    __builtin_amdgcn_sched_barrier(0);
    int c = 0;
#pragma unroll
    for (int i = 0; i < 16; ++i) c += __builtin_popcountll(m[i]);
    __builtin_amdgcn_sched_barrier(0);
    return c;
}

__device__ __forceinline__ void e2_tile(const bf16x8 (&Af)[2][4], const float (&wq)[2][2][8], const bf16x8 (&Bf)[4], LAS float* sc, int kt, int l31, int hi, int p0) {
    const int key = 32 * kt + l31;
#pragma unroll
    for (int mb = 0; mb < 2; ++mb) { f32x16 acc;
#pragma unroll
        for (int e = 0; e < 16; ++e) acc[e] = 0.f;
#pragma unroll
        for (int ks = 0; ks < 4; ++ks) acc = MFMA32(Af[mb][ks], Bf[ks], acc);
#pragma unroll
        for (int qq = 0; qq < 2; ++qq) { float s = 0.f;
#pragma unroll
            for (int h = 0; h < 8; ++h) s += wq[mb][qq][h] * fmaxf(acc[8 * qq + h], 0.f);
            const int ql = 4 * mb + 2 * hi + qq;
            sc[ql * 4096 + key] = (key <= p0 + ql) ? s : -__builtin_inff(); } }
}
__device__ __forceinline__ void e2_unit_loads(const bf16* EV, int i, int G, int l31, int hi, bf16x8 (&Af)[2][4], v4u (&wr)[2][2]) {
    const int b = i & 7, qt = 511 - (i >> 3); (void)G;
    const int p0 = qt * 8; const size_t mb0 = (size_t)b * SEQ;
    const int jj = l31 >> 3, hp = (l31 >> 2) & 1, ii = l31 & 3, ql = (jj >> 1) + 2 * hp, head = 4 * (jj & 1) + ii;
#pragma unroll
    for (int mb = 0; mb < 2; ++mb) { const bf16* qp = EV + (mb0 + p0 + 4 * mb + ql) * EVW + EC_IQ + head * 64 + 8 * hi;
#pragma unroll
        for (int ks = 0; ks < 4; ++ks) Af[mb][ks] = *(const bf16x8*)(qp + 16 * ks);
#pragma unroll
        for (int qq = 0; qq < 2; ++qq) wr[mb][qq] = *(const v4u*)(EV + (mb0 + p0 + 4 * mb + 2 * hi + qq) * EVW + EC_IW); }
}
__device__ __forceinline__ void e2_index_topk(const Frame& F, int j) {
    CArgs* ap = opq_p(F.ap); unsigned char* ws = as_global(ap->ws); LAS unsigned char* lds = opq_l(lds_base()); PHASE_UNIFORMS();
    const int lane = opq_v(lane_id()), tid = wave * 64 + lane, l31 = lane & 31, hi = lane >> 5;
    const bf16* EV = (const bf16*)(ws + WS_BIG);
    unsigned long long* BMK = (unsigned long long*)(ws + WS_AUX);
    LAS float* sc = (LAS float*)lds;
    bf16x8 Afn[2][4]; v4u wrn[2][2];
    e2_unit_loads(EV, bid < BATCH * 512 ? bid : 0, G, l31, hi, Afn, wrn);
#define E2_UNIT(i_, b_, qt_) do { (b_) = (i_) & 7; (qt_) = 511 - ((i_) >> 3); } while (0)
    bf16x8 Br[4][4];
    { int b0_, qt0_; E2_UNIT(bid < BATCH * 512 ? bid : 0, b0_, qt0_); const int nkt0 = (qt0_ * 8 + 8 + 31) >> 5; const bf16* kb0 = (const bf16*)(ws + WS_BIG + EV_IKT_OFF) + (size_t)((size_t)b0_ * SEQ >> 5) * 2048 + lane * 8;
#pragma unroll
      for (int u4 = 0; u4 < 2; ++u4) { const int k0 = wave + NWAVES * u4 < nkt0 ? wave + NWAVES * u4 : nkt0 - 1; const bf16* kp = kb0 + (size_t)k0 * 2048;
#pragma unroll
          for (int ks = 0; ks < 4; ++ks) Br[u4][ks] = *(const bf16x8*)(kp + 512 * ks); } }
    unsigned* qctr = (unsigned*)(ws + WS_CTL) + 1024 + 8 * j;
    volatile LAS unsigned* qtk = (volatile LAS unsigned*)(lds + MISC_OFF) + 16;
    int inxt;
    { if (tid == 0) qtk[0] = (unsigned)G + __hip_atomic_fetch_add(qctr, 1u, __ATOMIC_RELAXED, __HIP_MEMORY_SCOPE_AGENT);
      __syncthreads(); inxt = __builtin_amdgcn_readfirstlane((int)qtk[0]); __syncthreads(); }
        for (int i = bid; i < BATCH * 512; ) {
        int b, qt; E2_UNIT(i, b, qt);
        const int p0 = qt * 8; const size_t mb0 = (size_t)b * SEQ;
        const int nkt = (p0 + 8 + 31) >> 5, lim = nkt * 32;
        const int iN = inxt < BATCH * 512 ? inxt : i;
        unsigned tkt = 0u; if (tid == 0) tkt = __hip_atomic_fetch_add(qctr, 1u, __ATOMIC_RELAXED, __HIP_MEMORY_SCOPE_AGENT);
        int bn, qtn; E2_UNIT(iN, bn, qtn);
        const int nktn = (qtn * 8 + 8 + 31) >> 5; const bf16* kbn = (const bf16*)(ws + WS_BIG + EV_IKT_OFF) + (size_t)((size_t)bn * SEQ >> 5) * 2048 + lane * 8;
        bf16x8 Af[2][4]; float wq[2][2][8];
#pragma unroll
        for (int mb = 0; mb < 2; ++mb) {
#pragma unroll
            for (int ks = 0; ks < 4; ++ks) Af[mb][ks] = Afn[mb][ks];
#pragma unroll
            for (int qq = 0; qq < 2; ++qq) { const v4u wr = wrn[mb][qq];
                wq[mb][qq][0] = bflo(wr.x); wq[mb][qq][1] = bfhi(wr.x); wq[mb][qq][2] = bflo(wr.y); wq[mb][qq][3] = bfhi(wr.y);
                wq[mb][qq][4] = bflo(wr.z); wq[mb][qq][5] = bfhi(wr.z); wq[mb][qq][6] = bflo(wr.w); wq[mb][qq][7] = bfhi(wr.w); } }
        { const bf16* kbase = (const bf16*)(ws + WS_BIG + EV_IKT_OFF) + (size_t)(mb0 >> 5) * 2048 + lane * 8;
#pragma unroll
          for (int u4 = 2; u4 < 4; ++u4) { const int k0 = wave + NWAVES * u4 < nkt ? wave + NWAVES * u4 : nkt - 1; const bf16* kp = kbase + (size_t)k0 * 2048;
#pragma unroll
              for (int ks = 0; ks < 4; ++ks) Br[u4][ks] = *(const bf16x8*)(kp + 512 * ks); }
          for (int kt = wave; kt < nkt || kt == wave; kt += 4 * NWAVES) {
#pragma unroll
              for (int u4 = 0; u4 < 4; ++u4) {
                  asm volatile("" ::: "memory"); __builtin_amdgcn_sched_barrier(0);
                  if (kt + NWAVES * u4 < nkt) e2_tile(Af, wq, Br[u4], sc, kt + NWAVES * u4, l31, hi, p0);
                  { const bool own = kt + NWAVES * (u4 + 4) < nkt;
                    if (own || u4 < 2) {
                    const int kn = own ? kt + NWAVES * (u4 + 4) : (wave + NWAVES * u4 < nktn ? wave + NWAVES * u4 : nktn - 1); const bf16* kp = (own ? kbase : kbn) + (size_t)kn * 2048;
#pragma unroll
                    for (int ks = 0; ks < 4; ++ks) Br[u4][ks] = *(const bf16x8*)(kp + 512 * ks); } }
              }
          } }
        if (tid == 0) qtk[0] = (unsigned)G + tkt;
        __syncthreads();
        const int inn = __builtin_amdgcn_readfirstlane((int)qtk[0]);
        const int qpos = p0 + wave, n = qpos + 1;
        unsigned keys[64];
        { float raw[64];
#pragma unroll
          for (int j = 0; j < 64; ++j) raw[j] = sc[wave * 4096 + 64 * j + lane];
#pragma unroll
          for (int j = 0; j < 64; ++j) keys[j] = (64 * j + lane < lim) ? mono_key(raw[j]) : 0u; }
        __syncthreads();
        e2_unit_loads(EV, iN, G, l31, hi, Afn, wrn);
        unsigned long long myword = 0ull;
        if (n <= 256) {
            const int idx0 = 64 * lane;
            const int cnt = n - idx0; myword = cnt >= 64 ? ~0ull : (cnt <= 0 ? 0ull : ((1ull << cnt) - 1ull));
        } else {
            const int nrb = (lim + 1023) >> 10;
            unsigned T = 0u; bool exact = false; int cgt = 0;
            {
#define E2_COUNT(cand_, out_) do { int c_ = count_ge16<0>(keys, (cand_)); if (nrb > 1) c_ += count_ge16<16>(keys, (cand_)); if (nrb > 2) c_ += count_ge16<32>(keys, (cand_)); if (nrb > 3) c_ += count_ge16<48>(keys, (cand_)); (out_) = c_; } while (0)
#define E2_WAVE_RED(v_, op_) do { _Pragma("unroll") for (int o_ = 1; o_ < 64; o_ <<= 1) { const unsigned ot_ = (unsigned)__builtin_amdgcn_ds_bpermute((lane ^ o_) << 2, (int)(v_)); (v_) = op_(ot_, (v_)); } (v_) = (unsigned)__builtin_amdgcn_readfirstlane((int)(v_)); } while (0)
#define E2_UMAX(a_, b_) ((a_) > (b_) ? (a_) : (b_))
#define E2_UMIN(a_, b_) ((a_) < (b_) ? (a_) : (b_))
                unsigned lo, hi; int clo, chi;
                int cp; E2_COUNT(0x80000000u, cp);
                if (cp >= 256) {
                    unsigned km = 0u;
#pragma unroll
                    for (int jj = 0; jj < 16; ++jj) km = E2_UMAX(keys[jj], km);
                    if (nrb > 1) {
#pragma unroll
                        for (int jj = 16; jj < 32; ++jj) km = E2_UMAX(keys[jj], km); }
                    if (nrb > 2) {
#pragma unroll
                        for (int jj = 32; jj < 48; ++jj) km = E2_UMAX(keys[jj], km); }
                    if (nrb > 3) {
#pragma unroll
                        for (int jj = 48; jj < 64; ++jj) km = E2_UMAX(keys[jj], km); }
                    E2_WAVE_RED(km, E2_UMAX);
                    lo = 0x80000000u; clo = cp; hi = km + 1u; chi = 0;
                    bool ok = false; unsigned step = 1u << 23;
                    for (int w = 0; w < 4; ++w) { if (hi - lo <= step) { ok = true; break; } const unsigned Tw = hi - step; int c; E2_COUNT(Tw, c);
                        if (c >= 256) { lo = Tw; clo = c; ok = true; break; }
                        hi = Tw; chi = c; step <<= 1; }
                    if (!ok && hi - lo > 1u) { int c; E2_COUNT(0x80000001u, c);
                        if (c >= 256) { lo = 0x80000001u; clo = c; } else { hi = 0x80000001u; chi = c; } }
                } else {
                    unsigned kn = 0xFFFFFFFFu;
#pragma unroll
                    for (int jj = 0; jj < 16; ++jj) kn = E2_UMIN(keys[jj] - 0x00800000u, kn);
                    if (nrb > 1) {
#pragma unroll
                        for (int jj = 16; jj < 32; ++jj) kn = E2_UMIN(keys[jj] - 0x00800000u, kn); }
                    if (nrb > 2) {
#pragma unroll
                        for (int jj = 32; jj < 48; ++jj) kn = E2_UMIN(keys[jj] - 0x00800000u, kn); }
                    if (nrb > 3) {
#pragma unroll
                        for (int jj = 48; jj < 64; ++jj) kn = E2_UMIN(keys[jj] - 0x00800000u, kn); }
                    E2_WAVE_RED(kn, E2_UMIN);
                    lo = kn + 0x00800000u; clo = n; hi = 0x80000000u; chi = cp;
                    unsigned step = 1u << 23;
                    for (int w = 0; w < 4; ++w) { if (hi - lo <= step) break; const unsigned Tw = lo + step; int c; E2_COUNT(Tw, c);
                        if (c >= 256) { lo = Tw; clo = c; step <<= 1; } else { hi = Tw; chi = c; break; } }
                }
                for (int it = 0; ; ++it) {
                    if (clo == 256) { exact = true; T = lo; break; }
                    if (hi - lo == 1u) { T = lo; break; }
                    unsigned d;
                    if ((it % 3) == 2) d = (hi - lo) >> 1;
                    else { const float f = (float)(clo - 256) / (float)(clo - chi); d = (unsigned)((float)(hi - lo) * f); }
                    d = (unsigned)__builtin_amdgcn_readfirstlane((int)d);
                    d = d < 1u ? 1u : d; if (d > hi - lo - 1u) d = hi - lo - 1u;
                    const unsigned Tp = lo + d; int c; E2_COUNT(Tp, c);
                    if (c >= 256) { lo = Tp; clo = c; } else { hi = Tp; chi = c; }
                }
#undef E2_COUNT
#undef E2_WAVE_RED
#undef E2_UMAX
#undef E2_UMIN
                if (!exact) { cgt = count_gt16<0>(keys, T); if (nrb > 1) cgt += count_gt16<16>(keys, T); if (nrb > 2) cgt += count_gt16<32>(keys, T); if (nrb > 3) cgt += count_gt16<48>(keys, T); }
            }
            if (exact) {
#pragma unroll
                for (int j = 0; j < 64; ++j) { const unsigned long long word = __ballot(keys[j] >= T); if (lane == j) myword = word; }
            } else {
                int need = 256 - cgt;
#pragma unroll
                for (int j = 0; j < 64; ++j) { const unsigned long long gt = __ballot(keys[j] > T), eq = __ballot(keys[j] == T); unsigned long long keep = eq;
                    const int eqc = __popcll(eq); int take = need < eqc ? need : eqc; if (take < 0) take = 0;
                    if (take < eqc) { keep = 0ull; unsigned long long mm = eq; for (int k = 0; k < take; ++k) { const unsigned long long low = mm & (0ull - mm); keep |= low; mm ^= low; } }
                    need -= take;
                    const unsigned long long word = gt | keep;
                    if (lane == j) myword = word; }
            }
        }
        BMK[(mb0 + qpos) * 64 + lane] = myword;
        i = inxt; inxt = inn;
    }
}

__device__ __forceinline__ void e3_attention(const Frame& F) {
    CArgs* ap = opq_p(F.ap); unsigned char* ws = as_global(ap->ws); LAS unsigned char* lds = opq_l(lds_base()); PHASE_UNIFORMS();
    const int lane = opq_v(lane_id()), tid = wave * 64 + lane, l31 = lane & 31, hi = lane >> 5;
    bf16* EV = (bf16*)(ws + WS_BIG);
    const unsigned long long* BMK = (const unsigned long long*)(ws + WS_AUX);
    LAS unsigned char* Kl = lds;
    LAS unsigned char* Vt = lds + 9216;
        constexpr float SC2 = 0.125f * 1.4426950408889634f;
#define E3_UNIT(i_, b_, qt_) do { if (G == 256) { const int k_ = (i_) >> 8, w_ = (i_) & 255; (b_) = 2 * k_ + (w_ >> 7); (qt_) = (k_ & 1) ? 127 - (w_ & 127) : (w_ & 127); } else { (b_) = (i_) >> 7; (qt_) = (i_) & 127; } } while (0)
    const int ql = l31 >> 3, head = l31 & 7, skey = tid >> 3, spc = tid & 7;
    bf16x8 Qfn[4]; v4u kreg, vreg; unsigned long long mword;
    { int b0_, qt0_; E3_UNIT(bid < BATCH * 128 ? bid : 0, b0_, qt0_); const size_t mb00 = (size_t)b0_ * SEQ; const int qpos0 = qt0_ * 32 + 4 * wave + ql; const bf16* qrow0 = EV + (mb00 + qpos0) * EVW + EC_AQ + head * 64;
#pragma unroll
      for (int ks = 0; ks < 4; ++ks) Qfn[ks] = *(const bf16x8*)(qrow0 + 16 * ks + 8 * hi);
      kreg = *(const v4u*)(EV + (mb00 + skey) * EVW + EC_AK + 8 * spc); vreg = *(const v4u*)(EV + (mb00 + skey) * EVW + EC_AV + 8 * spc); mword = BMK[(mb00 + qpos0) * 64 + 0]; }
    for (int i = bid; i < BATCH * 128; i += G) {
        int b, qt; E3_UNIT(i, b, qt);
        const size_t mb0 = (size_t)b * SEQ; const int q0 = qt * 32, nkt = (qt >> 1) + 1;
        const int qpos = q0 + 4 * wave + ql;
        bf16* qrow = EV + (mb0 + qpos) * EVW + EC_AQ + head * 64;
        int bn, qtn; E3_UNIT(i + G < BATCH * 128 ? i + G : i, bn, qtn);
        const size_t mb0n = (size_t)bn * SEQ; const int qposn = qtn * 32 + 4 * wave + ql; const bf16* qrown = EV + (mb0n + qposn) * EVW + EC_AQ + head * 64;
        bf16x8 Qf[4];
#pragma unroll
        for (int ks = 0; ks < 4; ++ks) Qf[ks] = Qfn[ks];
        f32x16 accO[2];
#pragma unroll
        for (int e = 0; e < 16; ++e) { accO[0][e] = 0.f; accO[1][e] = 0.f; }
        float mrun = -__builtin_inff(), lrun = 0.f;
        for (int kt = 0; kt < nkt; ++kt) {
            __syncthreads();
            *(LAS v4u*)(Kl + skey * 144 + spc * 16) = kreg;
            *(LAS v4u*)(Vt + skey * 144 + spc * 16) = vreg;
            const unsigned long long mw = mword;
            __syncthreads();
            if (kt + 1 < nkt) { const size_t kr = mb0 + 64 * (kt + 1) + skey; kreg = *(const v4u*)(EV + kr * EVW + EC_AK + 8 * spc); vreg = *(const v4u*)(EV + kr * EVW + EC_AV + 8 * spc); mword = BMK[(mb0 + qpos) * 64 + kt + 1]; }
            else { kreg = *(const v4u*)(EV + (mb0n + skey) * EVW + EC_AK + 8 * spc); vreg = *(const v4u*)(EV + (mb0n + skey) * EVW + EC_AV + 8 * spc); mword = BMK[(mb0n + qposn) * 64 + 0];
#pragma unroll
                for (int ks = 0; ks < 4; ++ks) Qfn[ks] = *(const bf16x8*)(qrown + 16 * ks + 8 * hi); }
            bf16x8 Kfr[2][4], Vfr[2][2][2];
#pragma unroll
            for (int kb = 0; kb < 2; ++kb)
#pragma unroll
                for (int ks = 0; ks < 4; ++ks) Kfr[kb][ks] = *(const LAS bf16x8*)(Kl + (32 * kb + l31) * 144 + (16 * ks + 8 * hi) * 2);
#pragma unroll
            for (int db = 0; db < 2; ++db)
#pragma unroll
                for (int kb = 0; kb < 2; ++kb)
#pragma unroll
                    for (int s = 0; s < 2; ++s) {
                        const LAS unsigned char* va = Vt + (32 * kb + 16 * s + 4 * hi + ((lane & 15) >> 2)) * 144 + (32 * db + 16 * ((lane >> 4) & 1) + 4 * (lane & 3)) * 2;
                        const s16x4 lo = tr4(va), hi4 = tr4(va + 8 * 144);
                        Vfr[db][kb][s] = (bf16x8){lo[0], lo[1], lo[2], lo[3], hi4[0], hi4[1], hi4[2], hi4[3]}; }
            asm volatile("" ::: "memory"); __builtin_amdgcn_sched_barrier(0);
            f32x16 accS[2];
#pragma unroll
            for (int kb = 0; kb < 2; ++kb) {
#pragma unroll
                for (int e = 0; e < 16; ++e) accS[kb][e] = 0.f;
#pragma unroll
                for (int ks = 0; ks < 4; ++ks) accS[kb] = MFMA32(Kfr[kb][ks], Qf[ks], accS[kb]); }
            float mloc = -__builtin_inff();
#pragma unroll
            for (int kb = 0; kb < 2; ++kb)
#pragma unroll
                for (int e = 0; e < 16; ++e) mloc = fmaxf(mloc, accS[kb][e]);
            mloc = fmaxf(mloc, shx(mloc, 32, lane)) * SC2;
            const float mnew = fmaxf(mrun, mloc);
            const float alpha = __builtin_amdgcn_exp2f(mrun - mnew);
            mrun = mnew;
            const int mwh[2] = {(int)((unsigned)mw >> (4 * hi)), (int)((unsigned)(mw >> 32) >> (4 * hi))};
            bf16x8 Pf[2][2];
            f32x2_t ls2 = {0.f, 0.f}; const f32x2_t sc2 = {SC2, SC2}, nm2 = {-mnew, -mnew};
#pragma unroll
            for (int kb = 0; kb < 2; ++kb) { float p[16];
#pragma unroll
                for (int e = 0; e < 16; e += 2) { const f32x2_t a2 = {accS[kb][e], accS[kb][e + 1]}; const f32x2_t x2 = __builtin_elementwise_fma(a2, sc2, nm2);
                    f32x2_t p2;
#pragma unroll
                    for (int k = 0; k < 2; ++k) { const float pe = __builtin_amdgcn_exp2f(x2[k]);
                        unsigned sel; asm("v_bfe_i32 %0, %1, %2, 1" : "=v"(sel) : "v"(mwh[kb]), "n"(((e + k) & 3) + 8 * ((e + k) >> 2)));
                        p2[k] = __uint_as_float(__float_as_uint(pe) & sel); p[e + k] = p2[k]; }
                    ls2 += p2; }
#pragma unroll
                for (int s = 0; s < 2; ++s) { v4u t; t.x = pk2(p[8 * s + 0], p[8 * s + 1]); t.y = pk2(p[8 * s + 2], p[8 * s + 3]); t.z = pk2(p[8 * s + 4], p[8 * s + 5]); t.w = pk2(p[8 * s + 6], p[8 * s + 7]); Pf[kb][s] = __builtin_bit_cast(bf16x8, t); } }
            lrun = lrun * alpha + (ls2[0] + ls2[1]);
            if (__builtin_amdgcn_ballot_w64(alpha != 1.0f) != 0ull) {
#pragma unroll
                for (int db = 0; db < 2; ++db)
#pragma unroll
                    for (int e = 0; e < 16; ++e) accO[db][e] *= alpha; }
#pragma unroll
            for (int db = 0; db < 2; ++db) {
#pragma unroll
                for (int kb = 0; kb < 2; ++kb)
#pragma unroll
                    for (int s = 0; s < 2; ++s) accO[db] = MFMA32(Vfr[db][kb][s], Pf[kb][s], accO[db]); }
        }
        const float ltot = lrun + shx(lrun, 32, lane), rl = 1.0f / ltot;
#pragma unroll
        for (int db = 0; db < 2; ++db)
#pragma unroll
            for (int g = 0; g < 4; ++g) { const int d = 32 * db + 8 * g + 4 * hi;
                *(uint2*)(qrow + d) = make_uint2(pk2(accO[db][4 * g + 0] * rl, accO[db][4 * g + 1] * rl), pk2(accO[db][4 * g + 2] * rl, accO[db][4 * g + 3] * rl)); }
    }
}

__device__ __forceinline__ void g1_gla_local(const Frame& F, int j) {
    CArgs* ap = opq_p(F.ap); unsigned char* ws = as_global(ap->ws); LAS unsigned char* lds = opq_l(lds_base()); PHASE_UNIFORMS();
    const int lane = opq_v(lane_id()), tid = wave * 64 + lane, g4 = lane >> 4, l15 = lane & 15;
    bf16* EV = (bf16*)(ws + WS_BIG);
    bf16* LT = (bf16*)(ws + WS_BIG + EV_LT_OFF); float* GD = (float*)(ws + WS_SMALL + SM_GD);
    const bf16* w2t = (const bf16*)(ws + WS_SMALL + SM_W2T) + (size_t)j * 512 * 16; const float* b2 = as_global(ap->in[I_EV_GB2]) + (size_t)j * 512;
    LAS float* la = (LAS float*)lds;
    LAS unsigned char* Qt = lds + 32768;
    LAS unsigned char* Kt = Qt + 17408; LAS unsigned char* KE = Kt + 17408; LAS unsigned char* Vl = KE + 17408;
    LAS unsigned char* Pl = Vl + 17408;
    bf16x8 An_, Bn_[4]; float bbn_[4];
#define G1_ZLOADS(u_) do { const int bh_ = (u_) >> 6, c_ = (u_) & 63, b_ = bh_ >> 2, h_ = bh_ & 3; const size_t m0_ = (size_t)b_ * SEQ + c_ * 64; \
        An_ = *(const bf16x8*)(EV + (m0_ + 16 * (wave >> 1) + l15) * EVW + EC_GLR + 8 * (g4 & 1)); \
        _Pragma("unroll") for (int nn_ = 0; nn_ < 4; ++nn_) { const int d_ = 16 * (4 * (wave & 1) + nn_) + l15; Bn_[nn_] = *(const bf16x8*)(w2t + (size_t)(h_ * 128 + d_) * 16 + 8 * (g4 & 1)); bbn_[nn_] = b2[h_ * 128 + d_]; } } while (0)
    G1_ZLOADS(vcu < BATCH * 4 * 64 ? vcu : 0);
    unsigned* qctr1 = (unsigned*)(ws + WS_CTL) + 1024 + 8 * j + 1; volatile LAS unsigned* qtk1 = (volatile LAS unsigned*)(lds + MISC_OFF) + 17;
    int unxt;
    { if (tid == 0) qtk1[0] = (unsigned)G + __hip_atomic_fetch_add(qctr1, 1u, __ATOMIC_RELAXED, __HIP_MEMORY_SCOPE_AGENT);
      __syncthreads(); unxt = __builtin_amdgcn_readfirstlane((int)qtk1[0]); __syncthreads(); }
    for (int u = vcu; u < BATCH * 4 * 64; ) {
        const int uN = unxt < BATCH * 4 * 64 ? unxt : u;
        unsigned tkt = 0u; if (tid == 0) tkt = __hip_atomic_fetch_add(qctr1, 1u, __ATOMIC_RELAXED, __HIP_MEMORY_SCOPE_AGENT);
        const int bh = u >> 6, c = u & 63, b = bh >> 2, h = bh & 3; const size_t m0 = (size_t)b * SEQ + c * 64;
        const int t = tid >> 3, d0 = 16 * (tid & 7);
        v4u qr[2], kr[2], vr[2];
        { const bf16* qg = EV + (m0 + t) * EVW + EC_GQ + h * 128 + d0;
#pragma unroll
          for (int hf = 0; hf < 2; ++hf) { qr[hf] = *(const v4u*)(qg + 8 * hf); kr[hf] = *(const v4u*)(qg + (EC_GK - EC_GQ) + 8 * hf); vr[hf] = *(const v4u*)(qg + (EC_GV - EC_GQ) + 8 * hf); } }
        { const int mb = wave >> 1; const bf16x8 Z8 = (bf16x8){0, 0, 0, 0, 0, 0, 0, 0};
          bf16x8 A = An_; bf16x8 Bc[4]; float bbc[4];
#pragma unroll
          for (int nn = 0; nn < 4; ++nn) { Bc[nn] = Bn_[nn]; bbc[nn] = bbn_[nn]; }
          G1_ZLOADS(uN);
          asm volatile("" ::: "memory"); __builtin_amdgcn_sched_barrier(0);
          A = g4 < 2 ? A : Z8;
#pragma unroll
          for (int nn = 0; nn < 4; ++nn) { const int nb = 4 * (wave & 1) + nn, d = 16 * nb + l15;
              bf16x8 B = Bc[nn]; B = g4 < 2 ? B : Z8;
              const f32x4 z = MFMA16(A, B, zero4()); const float bb = bbc[nn];
#pragma unroll
              for (int i = 0; i < 4; ++i) la[(16 * mb + 4 * g4 + i) * 128 + d] = logsigmoidf_(z[i] + bb) * (1.0f / 16.0f); } }
        if (tid == 0) qtk1[0] = (unsigned)G + tkt;
        __syncthreads();
        const int unn = __builtin_amdgcn_readfirstlane((int)qtk1[0]);
        { const int d = tid & 127, seg = tid >> 7; float run = 0.f;
#pragma unroll
          for (int s = 0; s < 16; ++s) { run += la[(16 * seg + s) * 128 + d]; la[(16 * seg + s) * 128 + d] = run; }
          __syncthreads();
          float off = 0.f;
          for (int s2 = 0; s2 < seg; ++s2) off += la[(16 * s2 + 15) * 128 + d];
          __syncthreads();
#pragma unroll
          for (int s = 0; s < 16; ++s) la[(16 * seg + s) * 128 + d] += off; }
        __syncthreads();
        { bf16* qg = EV + (m0 + t) * EVW + EC_GQ + h * 128 + d0;
#pragma unroll
          for (int hf = 0; hf < 2; ++hf) {
              const float qv[8] = {bflo(qr[hf].x), bfhi(qr[hf].x), bflo(qr[hf].y), bfhi(qr[hf].y), bflo(qr[hf].z), bfhi(qr[hf].z), bflo(qr[hf].w), bfhi(qr[hf].w)};
              const float kv[8] = {bflo(kr[hf].x), bfhi(kr[hf].x), bflo(kr[hf].y), bfhi(kr[hf].y), bflo(kr[hf].z), bfhi(kr[hf].z), bflo(kr[hf].w), bfhi(kr[hf].w)};
              const f32x4 b0 = *(const LAS f32x4*)(la + t * 128 + d0 + 8 * hf), b1 = *(const LAS f32x4*)(la + t * 128 + d0 + 8 * hf + 4), g0 = *(const LAS f32x4*)(la + 63 * 128 + d0 + 8 * hf), g1 = *(const LAS f32x4*)(la + 63 * 128 + d0 + 8 * hf + 4);
              const float bcv[8] = {b0[0], b0[1], b0[2], b0[3], b1[0], b1[1], b1[2], b1[3]}, gdv[8] = {g0[0], g0[1], g0[2], g0[3], g1[0], g1[1], g1[2], g1[3]};
              float qt_[8], kt_[8], ke_[8];
#pragma unroll
              for (int e = 0; e < 8; ++e) { qt_[e] = qv[e] * __expf(bcv[e]) * 0.08838834764831845f; kt_[e] = kv[e] * __expf(-bcv[e]); ke_[e] = kv[e] * __expf(gdv[e] - bcv[e]); }
              if (t == 63) { float* gp = GD + ((size_t)bh * 64 + c) * 128 + d0 + 8 * hf;
                  *(f32x4*)gp = (f32x4){__expf(gdv[0]), __expf(gdv[1]), __expf(gdv[2]), __expf(gdv[3])}; *(f32x4*)(gp + 4) = (f32x4){__expf(gdv[4]), __expf(gdv[5]), __expf(gdv[6]), __expf(gdv[7])}; }
              v4u o; o.x = pk2(qt_[0], qt_[1]); o.y = pk2(qt_[2], qt_[3]); o.z = pk2(qt_[4], qt_[5]); o.w = pk2(qt_[6], qt_[7]);
              *(LAS v4u*)(Qt + t * 272 + (d0 + 8 * hf) * 2) = o; *(v4u*)(qg + 8 * hf) = o;
              o.x = pk2(kt_[0], kt_[1]); o.y = pk2(kt_[2], kt_[3]); o.z = pk2(kt_[4], kt_[5]); o.w = pk2(kt_[6], kt_[7]); *(LAS v4u*)(Kt + t * 272 + (d0 + 8 * hf) * 2) = o;
              o.x = pk2(ke_[0], ke_[1]); o.y = pk2(ke_[2], ke_[3]); o.z = pk2(ke_[4], ke_[5]); o.w = pk2(ke_[6], ke_[7]); *(LAS v4u*)(KE + t * 272 + (d0 + 8 * hf) * 2) = o;
              *(LAS v4u*)(Vl + t * 272 + (d0 + 8 * hf) * 2) = vr[hf]; } }
        __syncthreads();
        { const int mb = wave >> 1;
#pragma unroll
          for (int nn = 0; nn < 2; ++nn) { const int nb = 2 * (wave & 1) + nn; f32x4 acc = zero4();
              if (nb <= mb) {
#pragma unroll
                  for (int ks = 0; ks < 4; ++ks) { const bf16x8 A = *(const LAS bf16x8*)(Qt + (16 * mb + l15) * 272 + (32 * ks + 8 * g4) * 2), B = *(const LAS bf16x8*)(Kt + (16 * nb + l15) * 272 + (32 * ks + 8 * g4) * 2); acc = MFMA16(A, B, acc); } }
#pragma unroll
              for (int i = 0; i < 4; ++i) { const int tt = 16 * mb + 4 * g4 + i, s = 16 * nb + l15; *(LAS unsigned short*)(Pl + tt * 144 + s * 2) = (unsigned short)f2bf((nb <= mb && s <= tt) ? acc[i] : 0.f); } } }
        __syncthreads();
        { const int mb = wave >> 1;
#pragma unroll
          for (int nn = 0; nn < 4; ++nn) { const int nb = 4 * (wave & 1) + nn; f32x4 acc = zero4();
#pragma unroll
              for (int ks = 0; ks < 2; ++ks) { const bf16x8 A = *(const LAS bf16x8*)(Pl + (16 * mb + l15) * 144 + (32 * ks + 8 * g4) * 2); const bf16x8 B = tr_frag(Vl, 272, 32 * ks, 16 * nb, lane); acc = MFMA16(A, B, acc); }
#pragma unroll
              for (int i = 0; i < 4; ++i) *(LAS unsigned short*)(Qt + (16 * mb + 4 * g4 + i) * 272 + (16 * nb + l15) * 2) = (unsigned short)f2bf(acc[i]); }
          bf16* lt = LT + (size_t)u * 128 * 128;
#pragma unroll
          for (int nb = 0; nb < 8; ++nb) { f32x4 acc = zero4();
#pragma unroll
              for (int ks = 0; ks < 2; ++ks) { const bf16x8 A = tr_frag(KE, 272, 32 * ks, 16 * wave, lane), B = tr_frag(Vl, 272, 32 * ks, 16 * nb, lane); acc = MFMA16(A, B, acc); }
              *(v2u*)(lt + ((nb * 4 + (wave >> 1)) * 64 + (2 * (wave & 1) + (g4 >> 1)) * 16 + l15) * 8 + 4 * (g4 & 1)) = (v2u){pk2(acc[0], acc[1]), pk2(acc[2], acc[3])}; } }
        __syncthreads();
        { const int t = tid >> 3, d0 = 16 * (tid & 7); bf16* og = EV + (m0 + t) * EVW + EC_GK + h * 128 + d0;
          *(v4u*)og = *(const LAS v4u*)(Qt + t * 272 + d0 * 2); *(v4u*)(og + 8) = *(const LAS v4u*)(Qt + t * 272 + d0 * 2 + 16); }
        u = unxt; unxt = unn;
    }
}
__device__ __forceinline__ void g2_gla_scan(const Frame& F) {
    CArgs* ap = opq_p(F.ap); unsigned char* ws = as_global(ap->ws); PHASE_UNIFORMS(); const int tid = wave * 64 + opq_v(lane_id());
    bf16* LT = (bf16*)(ws + WS_BIG + EV_LT_OFF); const float* GD = (const float*)(ws + WS_SMALL + SM_GD);
    for (int e4 = vcu * 512 + tid; e4 < BATCH * 4 * 4096; e4 += G * 512) {
        const int bh = e4 >> 12, r = e4 & 4095, dk0 = 32 * ((r >> 7) & 3) + 8 * ((r & 127) >> 5) + 4 * (r & 1);
        f32x4 S = zero4();
        for (int c0 = 0; c0 < 64; c0 += 8) { v2u L[8]; f32x4 g[8];
#pragma unroll
            for (int i = 0; i < 8; ++i) { L[i] = *(const v2u*)(LT + ((size_t)(bh * 64 + c0 + i) * 4096 + r) * 4); g[i] = *(const f32x4*)(GD + ((size_t)bh * 64 + c0 + i) * 128 + dk0); }
#pragma unroll
            for (int i = 0; i < 8; ++i) { *(v2u*)(LT + ((size_t)(bh * 64 + c0 + i) * 4096 + r) * 4) = (v2u){pk2(S[0], S[1]), pk2(S[2], S[3])};
                S = g[i] * S + (f32x4){bflo(L[i].x), bfhi(L[i].x), bflo(L[i].y), bfhi(L[i].y)}; } }
    }
}
__device__ __forceinline__ void g3_gla_out(const Frame& F, int j) {
    CArgs* ap = opq_p(F.ap); unsigned char* ws = as_global(ap->ws); LAS unsigned char* lds = opq_l(lds_base()); PHASE_UNIFORMS();
    const int lane = opq_v(lane_id()), tid = wave * 64 + lane, g4 = lane >> 4, l15 = lane & 15;
    bf16* EV = (bf16*)(ws + WS_BIG);
    const bf16* LT = (const bf16*)(ws + WS_BIG + EV_LT_OFF);
    const float* gn = as_global(ap->in[I_EV_GNORM]) + (size_t)j * 512;
    LAS float* ol = (LAS float*)lds;
    const int mb = wave >> 1;
    bf16x8 An[4], Bn[4][4];
    { const int u = vcu < BATCH * 4 * 64 ? vcu : 0; const int bh = u >> 6, c = u & 63, b = bh >> 2, h = bh & 3; const size_t m0 = (size_t)b * SEQ + c * 64; const bf16* st = LT + (size_t)u * 128 * 128;
#pragma unroll
      for (int ks = 0; ks < 4; ++ks) An[ks] = *(const bf16x8*)(EV + (m0 + 16 * mb + l15) * EVW + EC_GQ + h * 128 + 32 * ks + 8 * g4);
#pragma unroll
      for (int nn = 0; nn < 4; ++nn)
#pragma unroll
          for (int ks = 0; ks < 4; ++ks) Bn[nn][ks] = *(const bf16x8*)(st + (((4 * (wave & 1) + nn) * 4 + ks) * 64 + lane) * 8); }
    unsigned* qctr3 = (unsigned*)(ws + WS_CTL) + 1024 + 8 * j + 2; volatile LAS unsigned* qtk3 = (volatile LAS unsigned*)(lds + MISC_OFF) + 18;
    int unxt;
    { if (tid == 0) qtk3[0] = (unsigned)G + __hip_atomic_fetch_add(qctr3, 1u, __ATOMIC_RELAXED, __HIP_MEMORY_SCOPE_AGENT);
      __syncthreads(); unxt = __builtin_amdgcn_readfirstlane((int)qtk3[0]); __syncthreads(); }
    for (int u = vcu; u < BATCH * 4 * 64; ) {
        const int uN = unxt < BATCH * 4 * 64 ? unxt : u;
        unsigned tkt = 0u; if (tid == 0) tkt = __hip_atomic_fetch_add(qctr3, 1u, __ATOMIC_RELAXED, __HIP_MEMORY_SCOPE_AGENT);
        const int bh = u >> 6, c = u & 63, b = bh >> 2, h = bh & 3; const size_t m0 = (size_t)b * SEQ + c * 64;
        const int t = tid >> 3, e0 = 16 * (tid & 7);
        bf16* gr = EV + (m0 + t) * EVW + EC_GR + h * 128 + e0;
        const bf16* oi = EV + (m0 + t) * EVW + EC_GK + h * 128 + e0; const v4u i0 = *(const v4u*)oi, i1 = *(const v4u*)(oi + 8);
        const v4u rr0 = *(const v4u*)gr, rr1 = *(const v4u*)(gr + 8);
        asm volatile("" ::: "memory"); __builtin_amdgcn_sched_barrier(0);
        {
#pragma unroll
          for (int nn = 0; nn < 4; ++nn) { const int nb = 4 * (wave & 1) + nn; f32x4 acc = zero4();
#pragma unroll
              for (int ks = 0; ks < 4; ++ks) acc = MFMA16(An[ks], Bn[nn][ks], acc);
#pragma unroll
              for (int i = 0; i < 4; ++i) ol[(16 * mb + 4 * g4 + i) * 132 + 16 * nb + l15] = acc[i]; } }
        { const int un = uN; const int bhn = un >> 6, cn = un & 63, bn = bhn >> 2, hn = bhn & 3; const size_t m0n = (size_t)bn * SEQ + cn * 64; const bf16* stn = LT + (size_t)un * 128 * 128;
#pragma unroll
          for (int ks = 0; ks < 4; ++ks) An[ks] = *(const bf16x8*)(EV + (m0n + 16 * mb + l15) * EVW + EC_GQ + hn * 128 + 32 * ks + 8 * g4);
#pragma unroll
          for (int nn = 0; nn < 4; ++nn)
#pragma unroll
              for (int ks = 0; ks < 4; ++ks) Bn[nn][ks] = *(const bf16x8*)(stn + (((4 * (wave & 1) + nn) * 4 + ks) * 64 + lane) * 8); }
        if (tid == 0) qtk3[0] = (unsigned)G + tkt;
        __syncthreads();
        const int unn = __builtin_amdgcn_readfirstlane((int)qtk3[0]);
        { float v[16], s = 0.f;
          { const float oiv[16] = {bflo(i0.x), bfhi(i0.x), bflo(i0.y), bfhi(i0.y), bflo(i0.z), bfhi(i0.z), bflo(i0.w), bfhi(i0.w), bflo(i1.x), bfhi(i1.x), bflo(i1.y), bfhi(i1.y), bflo(i1.z), bfhi(i1.z), bflo(i1.w), bfhi(i1.w)};
#pragma unroll
            for (int q4 = 0; q4 < 4; ++q4) { const f32x4 o4 = *(const LAS f32x4*)(ol + t * 132 + e0 + 4 * q4);
#pragma unroll
                for (int e = 0; e < 4; ++e) { v[4 * q4 + e] = o4[e] + oiv[4 * q4 + e]; s += v[4 * q4 + e]; } } }
          s += shx(s, 1, lane); s += shx(s, 2, lane); s += shx(s, 4, lane);
          const float mean = s * (1.f / 128.f); float s2 = 0.f;
#pragma unroll
          for (int e = 0; e < 16; ++e) { v[e] -= mean; s2 += v[e] * v[e]; }
          s2 += shx(s2, 1, lane); s2 += shx(s2, 2, lane); s2 += shx(s2, 4, lane);
          const float rstd = 1.f / sqrtf(s2 * (1.f / 128.f) + LN_EPS);
#pragma unroll
          for (int hf = 0; hf < 2; ++hf) { const v4u rr = hf ? rr1 : rr0; const float rv[8] = {bflo(rr.x), bfhi(rr.x), bflo(rr.y), bfhi(rr.y), bflo(rr.z), bfhi(rr.z), bflo(rr.w), bfhi(rr.w)}; float y[8];
#pragma unroll
              for (int e = 0; e < 8; ++e) { const float gg = gn[h * 128 + e0 + 8 * hf + e]; y[e] = v[8 * hf + e] * rstd * gg * (rv[e] * sigmoidf_(rv[e])); }
              v4u o; o.x = pk2(y[0], y[1]); o.y = pk2(y[2], y[3]); o.z = pk2(y[4], y[5]); o.w = pk2(y[6], y[7]); *(v4u*)(gr + 8 * hf) = o; } }
        __syncthreads();
        u = unxt; unxt = unn;
    }
}

__device__ __forceinline__ void even_mixer(const Frame& F, int j, const XcdBarrier& bar) {
    e2_index_topk(F, j); STAMP(2);
    g1_gla_local(F, j);
    xcd_barrier(bar, F.wave); STAMP(3);
    e3_attention(F); STAMP(4);
    g2_gla_scan(F);
    xcd_barrier(bar, F.wave); STAMP(5);
    g3_gla_out(F, j);
    xcd_barrier(bar, F.wave); STAMP(6);
}
__global__ void __launch_bounds__(NWAVES * 64, 2) fwd(Args args) {
    Frame F;
    F.wave = __builtin_amdgcn_readfirstlane((int)threadIdx.x >> 6);
    F.G = gridDim.x; { const int bx = blockIdx.x; F.vcu = (F.G % 8 == 0) ? (bx % 8) * (F.G / 8) + bx / 8 : bx; }
    F.ap = (CArgs*)__builtin_amdgcn_kernarg_segment_ptr();
    { LAS unsigned* mz = (LAS unsigned*)(lds_base() + MISC_OFF); for (int u = threadIdx.x; u < (LDS_BYTES - MISC_OFF) / 4; u += NWAVES * 64) mz[u] = 0u; }
    __syncthreads();
    XcdBarrier bar = xcd_barrier_post((unsigned*)(as_global(F.ap->ws) + WS_CTL) + CW_BAR, (volatile LAS unsigned*)(lds_base() + MISC_OFF) + 8, F.wave);
#define GRID_BAR() xcd_barrier(bar, F.wave)
#define WSP(off) ((bf16*)(as_global(opq_p(F.ap)->ws) + (off)))

    if (PROBE_GA >= 0 || PROBE_DLY >= 0) { if (F.wave == 0 && lane_id() == 0) ((volatile LAS unsigned*)(lds_base() + MISC_OFF))[31] = (unsigned)__builtin_amdgcn_s_memrealtime(); }
    x_to_bf16(F);
    copy_ln_vectors(F);
    const int ev_rem = ((M / 256) * (EVW / 256)) % F.G;
    const bool ev_fill = ev_rem > 0 && F.G - ev_rem >= 64;
    if (ev_fill) convert_layer(F, 0, 1 | 8); else { convert_layer(F, 0, 3); colsum_items(F, 0, 1); }
    fold_small(F);
    GRID_BAR(); STAMP(1);
    static_assert(pg8::LNW_XB == WS_XB && pg8::LNW_PS0 == WS_PS0 && pg8::LNW_PS1 == WS_SMALL + SM_PS1 && pg8::LNW_COLV == WS_SMALL + SM_COLV && pg8::LN_ST_OFF == LDS_ST_OFF && pg8::LN_RED_OFF == LDS_RED_OFF && pg8::LN_COL_OFF == LDS_COL_OFF, "layout constants");
#define PSBUF(k) ((const pg8::f32x4*)(as_global(opq_p(F.ap)->ws) + ((k) ? WS_SMALL + SM_PS1 : WS_PS0)))
#define COLV(i) ((const float*)(as_global(opq_p(F.ap)->ws) + WS_SMALL + SM_COLV) + (i) * 4096)
#define LNP(idx, ll) (as_global(opq_p(F.ap)->in[idx]) + (size_t)(ll) * DM)

    for (int l = 0; l < DEPTH; ++l) {
        const int j = l >> 1;
        const pg8::LNFold Lin{as_global(opq_p(F.ap)->ws), 0, 0, l > 0 ? 1 : 0};
        if ((l & 1) == 0) {
            { pg8::Gemm g{WSP(WS_XB), WSP(WS_WIN), M, EVW, DM, DM}; pg8::StaticOrder S; S.init(M, EVW, opq_s(F.G), opq_s((int)blockIdx.x));
              pg8::EpiEvenIn E{WSP(WS_BIG), EVW, WSP(WS_BIG + EV_IKT_OFF), EC_IK, Lin};
              pg8::gemm_phase<pg8::EpiEvenIn, pg8::StaticOrder, true, true>(opq_l(lds_base()), g, S, E, opq_s(F.wave)); }
            if (ev_fill && (int)blockIdx.x >= ev_rem) {
                Frame F2 = F; const int rk = (int)blockIdx.x - ev_rem, G2 = F.G - ev_rem; F2.G = G2; F2.vcu = (G2 % 8 == 0) ? (rk % 8) * (G2 / 8) + rk / 8 : rk;
                __syncthreads(); convert_layer(F2, l, 4); colsum_items(F2, l, 1); }
        } else {
            { pg8::Gemm g{WSP(WS_XB), WSP(WS_WIN), M, 4096, DM, DM}; pg8::StaticOrder S; S.init(M, 4096, opq_s(F.G), opq_s((int)blockIdx.x));
              pg8::EpiOddIn E{WSP(WS_BIG), (bf16*)as_global(opq_p(F.ap)->out), Lin};
              pg8::gemm_phase<pg8::EpiOddIn, pg8::StaticOrder, true, true>(opq_l(lds_base()), g, S, E, opq_s(F.wave)); }
        }
        GRID_BAR(); STAMP(0);
        if (l > 0) { if (ev_fill && (l & 1) == 0) convert_layer(F, l, 8); else { convert_layer(F, l, 2); colsum_items(F, l, 1); } }
        if (l + 1 < DEPTH) { convert_layer(F, l + 1, 1); colsum_items(F, l + 1, 0); }
        __syncthreads(); STAMP(1);
        if ((l & 1) == 0) {
            even_mixer(F, j, bar);
            { pg8::Gemm g{WSP(WS_BIG), WSP(WS_WOUT), M, DM, DM, EVW}; pg8::StaticOrder S; S.init(M, DM, opq_s(F.G), opq_s((int)blockIdx.x));
              pg8::EpiResidLN E{as_global(opq_p(F.ap)->ws), 0, 2 * 4 + (l > 0 ? l - 1 : 0), l > 0 ? 1 : 0, ALPHA};
              pg8::gemm_phase<pg8::EpiResidLN, pg8::StaticOrder, true, true>(opq_l(lds_base()), g, S, E, opq_s(F.wave)); }
        } else {
            odd_mixer(F, j, bar);
            { pg8::Gemm g{WSP(WS_BIG), WSP(WS_WOUT), M, DM, MI, MI}; pg8::StaticOrder S; S.init(M, DM, opq_s(F.G), opq_s((int)blockIdx.x));
              pg8::EpiResidLN E{as_global(opq_p(F.ap)->ws), 0, 2 * 4 + (l - 1), 1, ALPHA};
              pg8::gemm_phase<pg8::EpiResidLN, pg8::StaticOrder, true, true>(opq_l(lds_base()), g, S, E, opq_s(F.wave)); }
        }
        GRID_BAR(); STAMP(0);
        { pg8::Gemm g{WSP(WS_XB), WSP(WS_W1), M, FF, DM, DM}; pg8::StaticOrder S; S.init(M, FF, opq_s(F.G), opq_s((int)blockIdx.x));
          pg8::EpiBf16<1> E{WSP(WS_BIG), FF, pg8::LNFold{as_global(opq_p(F.ap)->ws), 1, 1, 1}};
          pg8::gemm_phase<pg8::EpiBf16<1>, pg8::StaticOrder, true, true>(opq_l(lds_base()), g, S, E, opq_s(F.wave)); }
        GRID_BAR(); STAMP(0);
        { pg8::Gemm g{WSP(WS_BIG), WSP(WS_W2), M, DM, FF, FF}; pg8::StaticOrder S; S.init(M, DM, opq_s(F.G), opq_s((int)blockIdx.x));
          pg8::EpiResidLN E{as_global(opq_p(F.ap)->ws), 1, 0 * 4 + l, 1, ALPHA};
          pg8::gemm_phase<pg8::EpiResidLN, pg8::StaticOrder, true, true>(opq_l(lds_base()), g, S, E, opq_s(F.wave)); }
        GRID_BAR(); STAMP(0);
    }
    ln_phase(F, I_LN2G, I_LN2B, DEPTH - 1, true);
}

extern "C" void kernel_launch(void* const* d_in, const int* in_sizes, int n_in, void* d_out, int out_size, void* d_ws, size_t ws_size, hipStream_t stream) {
    static int grid = 0;
    if (grid == 0) {
        if (n_in != 23 || in_sizes[0] != M * DM || out_size != M * DM || ws_size < WS_END) { fprintf(stderr, "kernel_launch: unexpected shapes / workspace (n_in %d, in0 %d, out %d, ws %zu); nothing launched\n", n_in, n_in > 0 ? in_sizes[0] : -1, out_size, ws_size); grid = -1; return; }
        int dev = 0, cus = 0, per_cu = 0;
        if (hipGetDevice(&dev) != hipSuccess || hipDeviceGetAttribute(&cus, hipDeviceAttributeMultiprocessorCount, dev) != hipSuccess) { grid = -1; return; }
        if (hipFuncSetAttribute((const void*)fwd, hipFuncAttributeMaxDynamicSharedMemorySize, LDS_BYTES) != hipSuccess) { fprintf(stderr, "kernel_launch: hipFuncSetAttribute failed\n"); grid = -1; return; }
        if (hipOccupancyMaxActiveBlocksPerMultiprocessor(&per_cu, (const void*)fwd, NWAVES * 64, LDS_BYTES) != hipSuccess || per_cu < 1) { fprintf(stderr, "kernel_launch: occupancy query reports %d\n", per_cu); }
        (void)hipGetLastError();
        grid = cus;
    }
    if (grid < 0) return;
    if (hipMemsetAsync((char*)d_ws + WS_CTL, 0, CTL_ZERO_BYTES, stream) != hipSuccess) return;
    Args a{};
    for (int i = 0; i < 23; ++i) a.in[i] = (const float*)d_in[i];
    a.out = (float*)d_out; a.ws = (unsigned char*)d_ws;
    hipLaunchKernelGGL(fwd, dim3(grid), dim3(NWAVES * 64), LDS_BYTES, stream, a);
}
```
